# Optimizing an MI355X kernel written in HIP

```python
import math
import jax, jax.numpy as jnp
from jax import lax
import numpy as np

D_MODEL = 2048
BATCH = 4
SEQ = 4096
DEPTH = 2

HEAD_DIM = 64
A_Q_HEADS = 16
A_KV_HEADS = 2
A_GROUP = A_Q_HEADS // A_KV_HEADS
A_WINDOW = 128
B_HEADS = 16
B_BRANCHES = ((128, 1), (512, 4), (2048, 16))
A_WIDTH = A_Q_HEADS * HEAD_DIM
A_KV_WIDTH = A_KV_HEADS * HEAD_DIM
B_WIDTH = B_HEADS * HEAD_DIM
MIX_WIDTH = A_WIDTH + B_WIDTH
IN_WIDTH = A_WIDTH + 2 * A_KV_WIDTH + 3 * B_WIDTH
IN_SPLITS = [A_WIDTH, A_WIDTH + A_KV_WIDTH, A_WIDTH + 2 * A_KV_WIDTH,
             A_WIDTH + 2 * A_KV_WIDTH + B_WIDTH, A_WIDTH + 2 * A_KV_WIDTH + 2 * B_WIDTH]
BLK = 128

MEM_LEN = 256
MEM_HEADS = 4
MEM_HEAD_DIM = D_MODEL // MEM_HEADS

N_EXPERTS = 64
TOP_K = 8
N_GROUPS = 8
TOPK_GROUPS = 4
D_EXPERT = 512
D_SHARED = 512
ROUTE_SCALE = 2.5
MOE_BLOCK = 128

ALPHA = (2.0 * DEPTH) ** 0.25
BETA = (8.0 * DEPTH) ** -0.25
LN_EPS = 1e-5
RMS_EPS = 1e-6

kernel_name = "hybrid_swa_sink_dilated_moe_deepnorm"


def layer_norm(x, g, b):
    xf = x.astype(jnp.float32)
    mu = jnp.mean(xf, axis=-1, keepdims=True)
    xc = xf - mu
    var = jnp.mean(xc * xc, axis=-1, keepdims=True)
    return (xc * lax.rsqrt(var + LN_EPS) * g + b).astype(x.dtype)


def rms_norm(x, g):
    xf = x.astype(jnp.float32)
    return xf * lax.rsqrt(jnp.mean(xf * xf, axis=-1, keepdims=True) + RMS_EPS) * g


def alibi_slopes(n):
    return 2.0 ** (-8.0 * jnp.arange(1, n + 1, dtype=jnp.float32) / n)


def banded_attention(q, k, v, max_offset, step, slopes, sinks):
    b, hk, g, L, hd = q.shape
    Lp = -(-L // BLK) * BLK
    pad = Lp - L
    nb = Lp // BLK
    q = jnp.pad(q, ((0, 0), (0, 0), (0, 0), (0, pad), (0, 0)))
    k = jnp.pad(k, ((0, 0), (0, 0), (BLK, pad), (0, 0)))
    v = jnp.pad(v, ((0, 0), (0, 0), (BLK, pad), (0, 0)))
    qb = q.reshape(b, hk, g, nb, BLK, hd)
    kb = jnp.concatenate([k[:, :, :Lp].reshape(b, hk, nb, BLK, hd),
                          k[:, :, BLK:].reshape(b, hk, nb, BLK, hd)], axis=3)
    vb = jnp.concatenate([v[:, :, :Lp].reshape(b, hk, nb, BLK, hd),
                          v[:, :, BLK:].reshape(b, hk, nb, BLK, hd)], axis=3)
    i = np.arange(BLK)[:, None]
    j = np.arange(2 * BLK)[None, :]
    offset = i + BLK - j
    band = (offset >= 0) & (offset <= max_offset)
    first = (np.arange(nb) == 0)[:, None, None]
    valid = jnp.asarray(band[None] & ~(first & (j < BLK)[None]))
    bias = -(slopes[:, :, None, None, None] * (step * jnp.asarray(offset, dtype=jnp.float32)))
    logits = jnp.einsum('bkgnqd,bknsd->bkgnqs', qb, kb,
                        preferred_element_type=jnp.float32) * (1.0 / math.sqrt(hd)) + bias
    logits = jnp.where(valid, logits, -jnp.inf)
    if sinks is not None:
        sink_col = jnp.broadcast_to(sinks.astype(jnp.float32)[None, :, :, None, None, None],
                                    (b, hk, g, nb, BLK, 1))
        logits = jnp.concatenate([logits, sink_col], axis=-1)
    m = jnp.max(logits, axis=-1, keepdims=True)
    e = jnp.exp(logits - m)
    s = jnp.sum(e, axis=-1, keepdims=True)
    probs = (e / s)[..., :2 * BLK]
    lse = (m + jnp.log(s))[..., 0]
    out = jnp.einsum('bkgnqs,bknsd->bkgnqd', probs, vb.astype(jnp.float32))
    out = out.reshape(b, hk, g, Lp, hd)[:, :, :, :L]
    lse = lse.reshape(b, hk, g, Lp)[:, :, :, :L]
    return out, lse


def dilated_branch(q, k, v, window, dilation, slopes):
    b, h, L, hd = q.shape
    Ld = L // dilation

    def to_res(t):
        return t.reshape(b, h, Ld, dilation, hd).transpose(0, 3, 1, 2, 4).reshape(b * dilation, h, Ld, hd)

    o, lse = banded_attention(to_res(q)[:, :, None], to_res(k), to_res(v),
                              window // dilation, dilation, slopes[:, None], None)
    o = o[:, :, 0].reshape(b, dilation, h, Ld, hd).transpose(0, 2, 3, 1, 4).reshape(b, h, L, hd)
    lse = lse[:, :, 0].reshape(b, dilation, h, Ld).transpose(0, 2, 3, 1).reshape(b, h, L)
    return o, lse


def mixing_sublayer(h, w_in, a_sinks, g_a, g_b, w_out):
    b, L, _ = h.shape
    proj = h @ w_in
    qa, ka, va, qb, kb, vb = jnp.split(proj, IN_SPLITS, axis=-1)
    qa = qa.reshape(b, L, A_KV_HEADS, A_GROUP, HEAD_DIM).transpose(0, 2, 3, 1, 4)
    ka = ka.reshape(b, L, A_KV_HEADS, HEAD_DIM).transpose(0, 2, 1, 3)
    va = va.reshape(b, L, A_KV_HEADS, HEAD_DIM).transpose(0, 2, 1, 3)
    oa, _ = banded_attention(qa, ka, va, A_WINDOW - 1, 1,
                             alibi_slopes(A_Q_HEADS).reshape(A_KV_HEADS, A_GROUP),
                             a_sinks.reshape(A_KV_HEADS, A_GROUP))
    oa = oa.transpose(0, 3, 1, 2, 4).reshape(b, L, A_WIDTH)
    qb = qb.reshape(b, L, B_HEADS, HEAD_DIM).transpose(0, 2, 1, 3)
    kb = kb.reshape(b, L, B_HEADS, HEAD_DIM).transpose(0, 2, 1, 3)
    vb = vb.reshape(b, L, B_HEADS, HEAD_DIM).transpose(0, 2, 1, 3)
    slopes_b = alibi_slopes(B_HEADS)
    outs, lses = [], []
    for window, dilation in B_BRANCHES:
        o, lse = dilated_branch(qb, kb, vb, window, dilation, slopes_b)
        outs.append(o)
        lses.append(lse)
    wts = jax.nn.softmax(jnp.stack(lses, axis=0), axis=0)
    ob = jnp.sum(wts[..., None] * jnp.stack(outs, axis=0), axis=0)
    ob = ob.transpose(0, 2, 1, 3).reshape(b, L, B_WIDTH)
    mixed = jnp.concatenate([rms_norm(oa, g_a), rms_norm(ob, g_b)], axis=-1).astype(h.dtype)
    return mixed @ w_out


def memory_sublayer(h, mem, wq, wk, wv, wo):
    b, L, d = h.shape
    m = mem.shape[1]
    q = (h @ wq).reshape(b, L, MEM_HEADS, MEM_HEAD_DIM)
    k = (mem @ wk).reshape(b, m, MEM_HEADS, MEM_HEAD_DIM)
    v = (mem @ wv).reshape(b, m, MEM_HEADS, MEM_HEAD_DIM)
    logits = jnp.einsum('bqhd,bkhd->bhqk', q, k,
                        preferred_element_type=jnp.float32) * (1.0 / math.sqrt(MEM_HEAD_DIM))
    p = jax.nn.softmax(logits, axis=-1)
    o = jnp.einsum('bhqk,bkhd->bqhd', p, v.astype(jnp.float32)).reshape(b, L, d)
    return o.astype(h.dtype) @ wo


def moe_sublayer(h, w_router, router_bias, w_gate, w_up, w_down, ws_gate, ws_up, ws_down):
    b, L, d = h.shape
    xt = h.reshape(-1, d)
    n = xt.shape[0]
    scores = jax.nn.sigmoid((xt @ w_router).astype(jnp.float32))
    sel = scores + router_bias.astype(jnp.float32)
    grp = sel.reshape(n, N_GROUPS, N_EXPERTS // N_GROUPS)
    grp_score = jnp.sum(lax.top_k(grp, 2)[0], axis=-1)
    _, top_groups = lax.top_k(grp_score, TOPK_GROUPS)
    group_mask = jnp.sum(jax.nn.one_hot(top_groups, N_GROUPS), axis=1) > 0
    expert_mask = jnp.repeat(group_mask, N_EXPERTS // N_GROUPS, axis=1)
    _, idx = lax.top_k(jnp.where(expert_mask, sel, -jnp.inf), TOP_K)
    gate = jnp.take_along_axis(scores, idx, axis=1)
    gate = gate / jnp.sum(gate, axis=-1, keepdims=True) * ROUTE_SCALE
    na = n * TOP_K
    flat_e = idx.reshape(-1)
    flat_tok = jnp.repeat(jnp.arange(n, dtype=jnp.int32), TOP_K)
    order = jnp.argsort(flat_e)
    se, stok, sgate = flat_e[order], flat_tok[order], gate.reshape(-1)[order]
    counts = jnp.bincount(flat_e, length=N_EXPERTS).astype(jnp.int32)
    starts = jnp.cumsum(counts) - counts
    padded = (counts + MOE_BLOCK - 1) // MOE_BLOCK * MOE_BLOCK
    padded_ends = jnp.cumsum(padded)
    padded_starts = padded_ends - padded
    pos = padded_starts[se] + (jnp.arange(na, dtype=jnp.int32) - starts[se])
    n_blocks = -(-na // MOE_BLOCK) + N_EXPERTS
    rows = n_blocks * MOE_BLOCK
    row_token = jnp.zeros((rows,), jnp.int32).at[pos].set(stok)
    row_gate = jnp.zeros((rows,), jnp.float32).at[pos].set(sgate)
    block_expert = jnp.minimum(
        jnp.searchsorted(padded_ends, jnp.arange(n_blocks, dtype=jnp.int32) * MOE_BLOCK, side='right'),
        N_EXPERTS - 1).astype(jnp.int32)

    def expert_block(blk):
        tok, g, e = blk
        xb = xt[tok]
        hid = jax.nn.silu(xb @ w_gate[e]) * (xb @ w_up[e])
        return (hid @ w_down[e]) * g[:, None].astype(xt.dtype)

    y_rows = lax.map(expert_block, (row_token.reshape(n_blocks, MOE_BLOCK),
                                    row_gate.reshape(n_blocks, MOE_BLOCK), block_expert))
    routed = jax.ops.segment_sum(y_rows.reshape(rows, d), row_token, num_segments=n)
    shared = (jax.nn.silu(xt @ ws_gate) * (xt @ ws_up)) @ ws_down
    return (routed + shared).reshape(b, L, d)


def setup_inputs(seed: int = 0) -> dict:
    key = jax.random.key(seed)
    ks = jax.random.split(key, 24)
    f32 = jnp.float32

    def nrm(k, shape, scale):
        return jax.random.normal(k, shape, f32) * scale

    def gain(k, shape):
        return 1.0 + 0.02 * jax.random.normal(k, shape, f32)

    return {
        "x": jax.random.normal(ks[0], (BATCH, SEQ, D_MODEL), f32),
        "mem": jax.random.normal(ks[1], (BATCH, MEM_LEN, D_MODEL), f32),
        "w_in": nrm(ks[2], (DEPTH, D_MODEL, IN_WIDTH), D_MODEL ** -0.5),
        "a_sinks": nrm(ks[3], (DEPTH, A_Q_HEADS), 1.0),
        "g_a": gain(ks[4], (DEPTH, A_WIDTH)),
        "g_b": gain(ks[5], (DEPTH, B_WIDTH)),
        "w_out": nrm(ks[6], (DEPTH, MIX_WIDTH, D_MODEL), BETA * MIX_WIDTH ** -0.5),
        "ln1_g": gain(ks[7], (DEPTH, D_MODEL)),
        "ln1_b": nrm(ks[8], (DEPTH, D_MODEL), 0.02),
        "wq_m": nrm(ks[9], (DEPTH, D_MODEL, D_MODEL), D_MODEL ** -0.5),
        "wk_m": nrm(ks[10], (DEPTH, D_MODEL, D_MODEL), D_MODEL ** -0.5),
        "wv_m": nrm(ks[11], (DEPTH, D_MODEL, D_MODEL), D_MODEL ** -0.5),
        "wo_m": nrm(ks[12], (DEPTH, D_MODEL, D_MODEL), BETA * D_MODEL ** -0.5),
        "ln2_g": gain(ks[13], (DEPTH, D_MODEL)),
        "ln2_b": nrm(ks[14], (DEPTH, D_MODEL), 0.02),
        "w_router": nrm(ks[15], (DEPTH, D_MODEL, N_EXPERTS), D_MODEL ** -0.5),
        "router_bias": nrm(ks[16], (DEPTH, N_EXPERTS), 0.01),
        "w_gate": nrm(ks[17], (DEPTH, N_EXPERTS, D_MODEL, D_EXPERT), D_MODEL ** -0.5),
        "w_up": nrm(ks[18], (DEPTH, N_EXPERTS, D_MODEL, D_EXPERT), D_MODEL ** -0.5),
        "w_down": nrm(ks[19], (DEPTH, N_EXPERTS, D_EXPERT, D_MODEL), BETA * D_EXPERT ** -0.5),
        "ws_gate": nrm(ks[20], (DEPTH, D_MODEL, D_SHARED), D_MODEL ** -0.5),
        "ws_up": nrm(ks[21], (DEPTH, D_MODEL, D_SHARED), D_MODEL ** -0.5),
        "ws_down": nrm(ks[22], (DEPTH, D_SHARED, D_MODEL), BETA * D_SHARED ** -0.5),
        "ln3_g": gain(ks[23], (DEPTH, D_MODEL)),
        "ln3_b": nrm(jax.random.fold_in(ks[23], 1), (DEPTH, D_MODEL), 0.02),
    }


def reference(x, mem, w_in, a_sinks, g_a, g_b, w_out, ln1_g, ln1_b,
              wq_m, wk_m, wv_m, wo_m, ln2_g, ln2_b,
              w_router, router_bias, w_gate, w_up, w_down, ws_gate, ws_up, ws_down,
              ln3_g, ln3_b):
    h = x
    for l in range(DEPTH):
        h = layer_norm(ALPHA * h + mixing_sublayer(h, w_in[l], a_sinks[l], g_a[l], g_b[l], w_out[l]),
                       ln1_g[l], ln1_b[l])
        h = layer_norm(ALPHA * h + memory_sublayer(h, mem, wq_m[l], wk_m[l], wv_m[l], wo_m[l]),
                       ln2_g[l], ln2_b[l])
        h = layer_norm(ALPHA * h + moe_sublayer(h, w_router[l], router_bias[l], w_gate[l], w_up[l],
                                                w_down[l], ws_gate[l], ws_up[l], ws_down[l]),
                       ln3_g[l], ln3_b[l])
    return h
```

```cpp
#include <hip/hip_runtime.h>
#include <cstdio>
#include <cstdint>

#ifndef MK_N_LAUNCHES
#define MK_N_LAUNCHES 0
#endif
#ifndef MK_KINDS
#define MK_KINDS 0x3ffff
#endif
#define KIND_EN(k) (((MK_KINDS) >> (k)) & 1)

#define GAS __attribute__((address_space(1)))
#define LAS __attribute__((address_space(3)))
typedef unsigned short bf16;
typedef short bf16x8 __attribute__((ext_vector_type(8)));
typedef short s16x4 __attribute__((ext_vector_type(4)));
typedef float f32x4 __attribute__((ext_vector_type(4)));
typedef float f32x2 __attribute__((ext_vector_type(2)));
typedef unsigned u32x4 __attribute__((ext_vector_type(4)));
typedef unsigned u32x2 __attribute__((ext_vector_type(2)));
typedef LAS unsigned char lds_u8;
typedef GAS unsigned gu32;

constexpr int D = 2048, NBATCH = 4, SEQ = 4096, M = NBATCH * SEQ, DEPTH = 2;
constexpr int INW = 4352;
constexpr int NE = 64, TOPK = 8, DE = 512;
constexpr float ALPHA = 1.4142135623730951f;
constexpr float LN_EPS = 1e-5f, RMS_EPS = 1e-6f;
constexpr float LOG2E = 1.4426950408889634f;
constexpr int RB_SHARED0 = 576;
constexpr int NROWS = (RB_SHARED0 + 64) * 256;
constexpr int MAXORD = 12;

constexpr size_t MiB = 1u << 20;
constexpr size_t WS_CTL = 0, CTL_ZERO_BYTES = 1 * MiB;
constexpr size_t WS_META = 1 * MiB;
constexpr size_t WS_TOKE = 2 * MiB, WS_TOKSLOT = 2 * MiB + 512 * 1024, WS_TOKGATE = 3 * MiB, WS_TOKPOS = 3 * MiB + 512 * 1024;
constexpr size_t WS_ROWTOK = 4 * MiB, WS_ROWGATE = 5 * MiB;
constexpr size_t WS_MEMB = 6 * MiB, WS_KC = 10 * MiB, WS_VT = 18 * MiB;
constexpr size_t WS_WIN = 26 * MiB, WS_WOUT = 43 * MiB, WS_WQ = 51 * MiB, WS_WO = 59 * MiB, WS_WGU = 67 * MiB, WS_WD = 327 * MiB;
constexpr size_t WS_H = 457 * MiB, WS_HB = 585 * MiB, WS_Y = 649 * MiB, WS_R = 777 * MiB;
constexpr size_t WS_PROJ = WS_R, WS_OA = WS_R + 136 * MiB, WS_OB = WS_R + 168 * MiB, WS_LSE = WS_R + 264 * MiB, WS_MIXED = WS_R + 267 * MiB;
constexpr size_t WS_Q = WS_R + 331 * MiB, WS_P = WS_R + 395 * MiB, WS_O = WS_R + 427 * MiB;
constexpr size_t WS_WKT = WS_R, WS_WVT = WS_R + 16 * MiB;
constexpr size_t WS_HID = WS_R, WS_YROWS = WS_R + 160 * MiB;
constexpr size_t WS_END = WS_R + 800 * MiB;
constexpr int CW_TMO = 0, CW_CODE = 1;
constexpr int CW_BAR = 4096;
constexpr int CW_CNT = 16384;

constexpr int RING_BYTES = 131072;
constexpr int AUX_OFF = RING_BYTES;
constexpr int TOKBUF_OFF = AUX_OFF, GATEBUF_OFF = AUX_OFF + MAXORD * 1024, BLKEXP_OFF = GATEBUF_OFF + MAXORD * 1024;
constexpr int MISC_OFF = BLKEXP_OFF + 2560;
constexpr int LDS_BYTES = MISC_OFF + 256;
static_assert(LDS_BYTES <= 160 * 1024 && (MISC_OFF % 16) == 0, "LDS map");

#define RLX_AGENT __ATOMIC_RELAXED, __HIP_MEMORY_SCOPE_AGENT
#define LDS_WAIT() asm volatile("s_waitcnt lgkmcnt(0)" ::: "memory")
#define VM_WAIT() asm volatile("s_waitcnt vmcnt(0)" ::: "memory")
__device__ __forceinline__ unsigned cvt_pk_bf16(float lo, float hi) { unsigned r; asm volatile("v_cvt_pk_bf16_f32 %0, %1, %2" : "=v"(r) : "v"(lo), "v"(hi)); return r; }
__device__ __forceinline__ float bf_lo(unsigned w) { return __uint_as_float(w << 16); }
__device__ __forceinline__ float bf_hi(unsigned w) { return __uint_as_float(w & 0xffff0000u); }
__device__ __forceinline__ float wave_sum(float v) {
#pragma unroll
    for (int o = 1; o < 64; o <<= 1) v += __shfl_xor(v, o);
    return v;
}

#define XB_TMO      128
#define XB_XCNT(j)  (256  + 64 * (j))
#define XB_XSUB(j)  (1280 + 64 * (j))
#define XB_XGEN(j)  (2304 + 64 * (j))
#define XB_TOP      3328
#define XB_TOPGEN   3392
#define XCD_BAR_WORDS 3456
#define XB_SPIN_CAP (1u << 18)
__device__ __forceinline__ unsigned xb_ld(unsigned* p)              { return __hip_atomic_load(p, __ATOMIC_RELAXED, __HIP_MEMORY_SCOPE_AGENT); }
__device__ __forceinline__ unsigned xb_add(unsigned* p, unsigned v) { return __hip_atomic_fetch_add(p, v, __ATOMIC_RELAXED, __HIP_MEMORY_SCOPE_AGENT); }
__device__ __forceinline__ unsigned xb_xcc_id() { return (unsigned)__builtin_amdgcn_s_getreg((3 << 11) | 20) & 0xFu; }
#define XB_SPIN(cond, bar) do { unsigned _sp = 0; while (cond) { __builtin_amdgcn_s_sleep(1); \
    if ((++_sp & 255u) == 0u) { if (xb_ld(&(bar)[XB_TMO])) break; if (_sp > XB_SPIN_CAP) { atomicAdd(&(bar)[XB_TMO], 1u); break; } } } } while (0)
struct XcdBarrier { unsigned* bar; unsigned x; volatile LAS unsigned* st; };
__device__ __forceinline__ XcdBarrier xcd_barrier_post(unsigned* bar, volatile LAS unsigned* st) {
    XcdBarrier b; b.bar = bar; b.x = xb_xcc_id(); b.st = st;
    if (threadIdx.x == 0) (void)xb_add(&bar[XB_XCNT(b.x)], 1u);
    return b;
}
__device__ __forceinline__ void xcd_barrier_complete(unsigned* bar, unsigned x, unsigned& nloc, unsigned& nx) {
    const unsigned G = gridDim.x * gridDim.y * gridDim.z;
    unsigned sum, cnt, mine, sp = 0u;
    for (;;) {
        sum = 0u; cnt = 0u; mine = 0u;
#pragma unroll
        for (unsigned j = 0; j < 16; ++j) { const unsigned c = xb_ld(&bar[XB_XCNT(j)]); sum += c; cnt += (c > 0u) ? 1u : 0u; mine = (j == x) ? c : mine; }
        if (sum == G) break;
        __builtin_amdgcn_s_sleep(1);
        if ((++sp & 255u) == 0u) { if (xb_ld(&bar[XB_TMO])) break; if (sp > XB_SPIN_CAP) { atomicAdd(&bar[XB_TMO], 1u); break; } }
    }
    nloc = mine > 0u ? mine : 1u; nx = cnt > 0u ? cnt : 1u;
}
__device__ __forceinline__ void xcd_barrier(const XcdBarrier& b) {
    asm volatile("s_waitcnt vmcnt(0)" ::: "memory");
    __syncthreads();
    if (threadIdx.x == 0) {
        unsigned* bar = b.bar;
        __builtin_amdgcn_s_waitcnt(0);
        unsigned nloc = b.st[0], nx = b.st[1];
        if (nloc == 0u) { xcd_barrier_complete(bar, b.x, nloc, nx); b.st[0] = nloc; b.st[1] = nx; }
        const unsigned old = xb_add(&bar[XB_XSUB(b.x)], 1u);
        const unsigned gen = old / nloc;
        if (old + 1u == (gen + 1u) * nloc) {
            __builtin_amdgcn_fence(__ATOMIC_RELEASE, "agent");
            asm volatile("s_waitcnt vmcnt(0)" ::: "memory");
            const unsigned og = xb_add(&bar[XB_TOP], 1u);
            const unsigned tg = og / nx;
            if (og + 1u == (tg + 1u) * nx) xb_add(&bar[XB_TOPGEN], 1u);
            else XB_SPIN(xb_ld(&bar[XB_TOPGEN]) == tg, bar);
            __builtin_amdgcn_fence(__ATOMIC_ACQUIRE, "agent");
            xb_add(&bar[XB_XGEN(b.x)], 1u);
            asm volatile("s_waitcnt vmcnt(0)" ::: "memory");
        } else {
            XB_SPIN(xb_ld(&bar[XB_XGEN(b.x)]) == gen, bar);
            __builtin_amdgcn_fence(__ATOMIC_ACQUIRE, "agent");
            asm volatile("s_waitcnt vmcnt(0)" ::: "memory");
        }
    }
    __syncthreads();
}

namespace pg8 {
constexpr int BM = 256, BK = 64, HALF = 128, HTB = HALF * BK * 2, STAGE_BYTES = 8 * HTB, NXCD = 8, WGM = 8;
__host__ __device__ __forceinline__ int lds_byte(int r, int c) { const int st = (r >> 4) * 2 + (c >> 5), rr = r & 15, cc = c & 31, ob = rr * 64 + cc * 2; return st * 1024 + (ob ^ (((ob >> 9) & 1) << 5)); }
__host__ __device__ __forceinline__ void stage_rc(int b, int& R, int& C) { const int st = b / 1024, sb = b % 1024, swz = sb ^ (((sb >> 9) & 1) << 5); R = (st >> 1) * 16 + swz / 64; C = (st & 1) * 32 + (swz % 64) / 2; }
__host__ __device__ __forceinline__ int perm32(int rho) { const int n = rho >> 4, i = rho & 15; return 8 * (i >> 2) + 4 * n + (i & 3); }

struct Unit { int pm, pn, ex, ord; };

struct StaticOrder {
    int nM, nN, nwg, G, c;
    __device__ void init(int nM_, int nN_, int G_, int c_) { nM = nM_; nN = nN_; nwg = nM * nN; G = G_; c = c_; }
    __device__ bool next(int i, Unit& u) const {
        const long L = (long)i * G + c; if (L >= nwg) return false;
        int wgid = (int)L; { const int q = nwg / NXCD, r = nwg % NXCD, xcd = wgid % NXCD, off = wgid / NXCD; wgid = (xcd < r ? xcd * (q + 1) : r * (q + 1) + (xcd - r) * q) + off; }
        const int nig = WGM * nN, gid = wgid / nig, fm = gid * WGM, gsz = (nM - fm) < WGM ? (nM - fm) : WGM;
        u.pm = fm + ((wgid % nig) % gsz); u.pn = (wgid % nig) / gsz; u.ex = 0; u.ord = i; return true;
    }
};

struct ProbStatic {
    const char* A0; const char* B0; int lda, ldb, K;
    size_t a_pm_step, a_pn_step; int a_pn_shift; size_t b_pn_step, b_batch_step; int batch_div;
    StaticOrder S;
    __device__ __forceinline__ bool next(int i, Unit& u) const { return S.next(i, u); }
    __device__ __forceinline__ const char* a_base(const Unit& u) const { return A0 + (size_t)u.pm * a_pm_step + (size_t)(u.pn >> a_pn_shift) * a_pn_step; }
    __device__ __forceinline__ const char* b_base(const Unit& u) const { return B0 + (size_t)u.pn * b_pn_step + (size_t)(u.pm / batch_div) * b_batch_step; }
    __device__ __forceinline__ void a_offs(const Unit&, const int (&R)[2], const int (&C)[2], unsigned (&vo)[2][2]) const {
#pragma unroll
        for (int h = 0; h < 2; ++h)
#pragma unroll
            for (int i = 0; i < 2; ++i) vo[h][i] = (unsigned)((R[i] + HALF * h) * lda + C[i]) * 2u;
    }
};

template <bool GATHER> struct ProbMoe {
    const char* A0; const char* B0; int lda, ldb, K, npn; size_t b_e_step, b_pn_step;
    const LAS int* blkexp; const LAS int* tokbuf; int nblk, ntot, chunk, xcd, rank, nrank;
    __device__ __forceinline__ bool next(int i, Unit& u) const {
        const int idx = xcd * chunk + i * nrank + rank; int lim = (xcd + 1) * chunk; lim = lim < ntot ? lim : ntot;
        if (idx >= lim || i * nrank + rank >= chunk) return false;
        const int lb = idx / npn; u.pn = idx - lb * npn;
        if (lb < nblk) { u.pm = lb; u.ex = blkexp[lb]; } else { u.pm = RB_SHARED0 + (lb - nblk); u.ex = NE; }
        u.ord = i; return true;
    }
    __device__ __forceinline__ const char* a_base(const Unit& u) const { return GATHER ? A0 : A0 + (size_t)u.pm * BM * lda * 2; }
    __device__ __forceinline__ const char* b_base(const Unit& u) const { return B0 + (size_t)u.ex * b_e_step + (size_t)u.pn * b_pn_step; }
    __device__ __forceinline__ void a_offs(const Unit& u, const int (&R)[2], const int (&C)[2], unsigned (&vo)[2][2]) const {
#pragma unroll
        for (int h = 0; h < 2; ++h)
#pragma unroll
            for (int i = 0; i < 2; ++i) {
                if (GATHER) { const int tok = tokbuf[u.ord * 256 + R[i] + HALF * h]; vo[h][i] = (unsigned)(tok * lda + C[i]) * 2u; }
                else vo[h][i] = (unsigned)((R[i] + HALF * h) * lda + C[i]) * 2u;
            }
    }
};

struct EpiBf16 {
    static constexpr bool PERM = true, AFTER_DRAIN = false;
    bf16* O; int ldc; float scale;
    __device__ __forceinline__ void operator()(const f32x4 (&acc)[2][2][4][2], const Unit& u, int wr, int wc, int fr, int fq) const {
        const int row0 = u.pm * BM + wr * 64 + fr, col0 = u.pn * BM + wc * 32 + 8 * fq;
#pragma unroll
        for (int ai = 0; ai < 2; ++ai)
#pragma unroll
            for (int m = 0; m < 4; ++m) { bf16* rowp = O + (size_t)(row0 + ai * HALF + m * 16) * ldc + col0;
#pragma unroll
                for (int bj = 0; bj < 2; ++bj) { const f32x4 v0 = acc[ai][bj][m][0] * scale, v1 = acc[ai][bj][m][1] * scale;
                    u32x4 w; w.x = cvt_pk_bf16(v0[0], v0[1]); w.y = cvt_pk_bf16(v0[2], v0[3]); w.z = cvt_pk_bf16(v1[0], v1[1]); w.w = cvt_pk_bf16(v1[2], v1[3]);
                    *(u32x4*)(rowp + bj * HALF) = w; } }
    }
};
struct EpiResF32 {
    static constexpr bool PERM = false, AFTER_DRAIN = false;
    const float* base; float* Y; int ldc; float alpha;
    __device__ __forceinline__ void operator()(const f32x4 (&acc)[2][2][4][2], const Unit& u, int wr, int wc, int fr, int fq) const {
        const int row0 = u.pm * BM + wr * 64 + fr, col0 = u.pn * BM + wc * 32 + 4 * fq;
#pragma unroll
        for (int ai = 0; ai < 2; ++ai)
#pragma unroll
            for (int m = 0; m < 4; ++m) { const size_t off = (size_t)(row0 + ai * HALF + m * 16) * ldc + col0;
#pragma unroll
                for (int bj = 0; bj < 2; ++bj)
#pragma unroll
                    for (int n = 0; n < 2; ++n) { const f32x4 b = *(const f32x4*)(base + off + bj * HALF + n * 16); *(f32x4*)(Y + off + bj * HALF + n * 16) = b * alpha + acc[ai][bj][m][n]; } }
    }
};
struct EpiSwiGLU {
    static constexpr bool PERM = true, AFTER_DRAIN = false;
    bf16* Hd; const LAS float* gatebuf;
    __device__ __forceinline__ void operator()(const f32x4 (&acc)[2][2][4][2], const Unit& u, int wr, int wc, int fr, int fq) const {
        const int r0 = wr * 64 + fr, col0 = u.pn * HALF + wc * 32 + 8 * fq;
#pragma unroll
        for (int ai = 0; ai < 2; ++ai)
#pragma unroll
            for (int m = 0; m < 4; ++m) { const int r = r0 + ai * HALF + m * 16; const float gt = gatebuf[u.ord * 256 + r];
                float o[8];
#pragma unroll
                for (int n = 0; n < 2; ++n)
#pragma unroll
                    for (int e = 0; e < 4; ++e) { const float g = acc[ai][0][m][n][e], up = acc[ai][1][m][n][e];
                        const float sg = g * __builtin_amdgcn_rcpf(1.0f + __builtin_amdgcn_exp2f(-g * LOG2E)); o[n * 4 + e] = sg * up * gt; }
                u32x4 w; w.x = cvt_pk_bf16(o[0], o[1]); w.y = cvt_pk_bf16(o[2], o[3]); w.z = cvt_pk_bf16(o[4], o[5]); w.w = cvt_pk_bf16(o[6], o[7]);
                *(u32x4*)(Hd + (size_t)(u.pm * BM + r) * DE + col0) = w; }
    }
};
struct EpiSoftmax {
    static constexpr bool PERM = true, AFTER_DRAIN = true;
    bf16* O; int ldc; float scale2;
    __device__ __forceinline__ void operator()(const f32x4 (&)[2][2][4][2], const Unit&, int, int, int, int) const {}
    __device__ __forceinline__ void fused(f32x4 (&acc)[2][2][4][2], const Unit& u, int wr, int wc, int fr, int fq, lds_u8* lds, int wid, int lane) const {
        LAS float* X = (LAS float*)lds;
        LAS float* Z = (LAS float*)(lds + 4096);
        float mx[2][4];
#pragma unroll
        for (int ai = 0; ai < 2; ++ai)
#pragma unroll
            for (int m = 0; m < 4; ++m) { float v = -3.0e38f;
#pragma unroll
                for (int bj = 0; bj < 2; ++bj)
#pragma unroll
                    for (int n = 0; n < 2; ++n) { acc[ai][bj][m][n] = acc[ai][bj][m][n] * scale2; const f32x4 x = acc[ai][bj][m][n]; v = fmaxf(v, fmaxf(fmaxf(x[0], x[1]), fmaxf(x[2], x[3]))); }
                v = fmaxf(v, __shfl_xor(v, 16)); v = fmaxf(v, __shfl_xor(v, 32));
                if (fq == 0) X[(ai * HALF + wr * 64 + m * 16 + fr) * 4 + wc] = v; }
        asm volatile("s_waitcnt lgkmcnt(0)" ::: "memory"); __builtin_amdgcn_s_barrier(); asm volatile("" ::: "memory");
#pragma unroll
        for (int ai = 0; ai < 2; ++ai)
#pragma unroll
            for (int m = 0; m < 4; ++m) { const int r = ai * HALF + wr * 64 + m * 16 + fr; const f32x4 t = *(const LAS f32x4*)(X + r * 4);
                const float mm = fmaxf(fmaxf(t[0], t[1]), fmaxf(t[2], t[3])); mx[ai][m] = mm; float s = 0.f;
#pragma unroll
                for (int bj = 0; bj < 2; ++bj)
#pragma unroll
                    for (int n = 0; n < 2; ++n) { f32x4 x = acc[ai][bj][m][n];
#pragma unroll
                        for (int e = 0; e < 4; ++e) x[e] = __builtin_amdgcn_exp2f(x[e] - mm);
                        acc[ai][bj][m][n] = x; s += (x[0] + x[1]) + (x[2] + x[3]); }
                s += __shfl_xor(s, 16); s += __shfl_xor(s, 32);
                if (fq == 0) Z[r * 4 + wc] = s; }
        asm volatile("s_waitcnt lgkmcnt(0)" ::: "memory"); __builtin_amdgcn_s_barrier(); asm volatile("" ::: "memory");
        const int row0 = u.pm * BM + wr * 64 + fr, col0 = u.pn * BM + wc * 32 + 8 * fq;
#pragma unroll
        for (int ai = 0; ai < 2; ++ai)
#pragma unroll
            for (int m = 0; m < 4; ++m) { const int r = ai * HALF + wr * 64 + m * 16 + fr; const f32x4 t = *(const LAS f32x4*)(Z + r * 4);
                const float inv = 1.0f / ((t[0] + t[1]) + (t[2] + t[3]));
                bf16* rowp = O + (size_t)(row0 + ai * HALF + m * 16) * ldc + col0;
#pragma unroll
                for (int bj = 0; bj < 2; ++bj) { const f32x4 v0 = acc[ai][bj][m][0] * inv, v1 = acc[ai][bj][m][1] * inv;
                    u32x4 w; w.x = cvt_pk_bf16(v0[0], v0[1]); w.y = cvt_pk_bf16(v0[2], v0[3]); w.z = cvt_pk_bf16(v1[0], v1[1]); w.w = cvt_pk_bf16(v1[2], v1[3]);
                    *(u32x4*)(rowp + bj * HALF) = w; } }
        (void)mx; (void)wid; (void)lane;
    }
};

template <class Epi, class Prob, bool ALIGN_EPI>
__device__ __forceinline__ void gemm_phase(lds_u8* lds, const Prob& P, const Epi& E, const int tid) {
    const int wid = __builtin_amdgcn_readfirstlane(tid >> 6), lane = tid & 63, wr = wid >> 2, wc = wid & 3, fr = lane & 15, fq = lane >> 4;
    const int nt = P.K / BK;
    int Rr[2], Cc[2]; unsigned voffB[2];
#pragma unroll
    for (int i = 0; i < 2; ++i) { stage_rc(tid * 16 + i * 8192, Rr[i], Cc[i]); const int Rb = Epi::PERM ? ((Rr[i] & ~31) + perm32(Rr[i] & 31)) : Rr[i];
        voffB[i] = (unsigned)(Rb * P.ldb + Cc[i]) * 2u; }
    const size_t kstep = (size_t)(BK * 2);
    const size_t hstepB = (size_t)HALF * P.ldb * 2;
    const unsigned ldsw = (unsigned)wid * 1024u;
    const int aoff = lds_byte(wr * 64 + fr, fq * 8), boff = lds_byte(wc * 32 + fr, fq * 8);
#define PG8_SA(b, h) (((b) * 2 + (h)) * HTB)
#define PG8_SB(b, h) ((4 + (b) * 2 + (h)) * HTB)
#define PG8_STAGE(bufoff, gbase, voff) do { _Pragma("unroll") for (int _i = 0; _i < 2; ++_i) \
        __builtin_amdgcn_global_load_lds((const unsigned*)((const char*)(gbase) + (voff)[_i]), (LAS unsigned*)(lds + (bufoff) + ldsw + _i * 8192), 16, 0, 0); } while (0)
#define PG8_LDA(dst, b, h) do { _Pragma("unroll") for (int m = 0; m < 4; ++m) _Pragma("unroll") for (int k = 0; k < 2; ++k) dst[m][k] = *(const LAS bf16x8*)(lds + PG8_SA(b, h) + aoff + m * 2048 + k * 1024); } while (0)
#define PG8_LDB(dst, b, h) do { _Pragma("unroll") for (int n = 0; n < 2; ++n) _Pragma("unroll") for (int k = 0; k < 2; ++k) dst[n][k] = *(const LAS bf16x8*)(lds + PG8_SB(b, h) + boff + n * 2048 + k * 1024); } while (0)
#define PG8_MMA(ai, bj, At, Bt) do { __builtin_amdgcn_s_setprio(1); _Pragma("unroll") for (int m = 0; m < 4; ++m) _Pragma("unroll") for (int n = 0; n < 2; ++n) _Pragma("unroll") for (int k = 0; k < 2; ++k) \
        acc[ai][bj][m][n] = __builtin_amdgcn_mfma_f32_16x16x32_bf16(Bt[n][k], At[m][k], acc[ai][bj][m][n], 0, 0, 0); __builtin_amdgcn_s_setprio(0); } while (0)
#define PG8_WAIT_V(n) asm volatile("s_waitcnt vmcnt(" #n ")" ::: "memory")
#define PG8_WAIT_L(n) asm volatile("s_waitcnt lgkmcnt(" #n ")" ::: "memory")
#define PG8_BAR __builtin_amdgcn_s_barrier()
#define PG8_SCHED __builtin_amdgcn_sched_barrier(0)
    Unit cur, nxt; int ui = 0;
    if (!P.next(0, cur)) return;
    f32x4 acc[2][2][4][2];
#pragma unroll
    for (int a = 0; a < 2; ++a)
#pragma unroll
        for (int b = 0; b < 2; ++b)
#pragma unroll
            for (int m = 0; m < 4; ++m)
#pragma unroll
                for (int n = 0; n < 2; ++n) acc[a][b][m][n] = (f32x4){0.f, 0.f, 0.f, 0.f};
    bf16x8 At[4][2], B0[2][2], B1[2][2];
    unsigned vA[2][2], nvA[2][2];
    P.a_offs(cur, Rr, Cc, vA);
    const char* cA = P.a_base(cur); const char* cB = P.b_base(cur);
    PG8_STAGE(PG8_SB(0, 0), cB, voffB); PG8_STAGE(PG8_SB(0, 1), cB + hstepB, voffB); PG8_STAGE(PG8_SA(0, 0), cA, vA[0]); PG8_STAGE(PG8_SA(0, 1), cA, vA[1]);
    if (wr == 1) PG8_BAR;
    PG8_WAIT_V(2); PG8_BAR;
    PG8_STAGE(PG8_SB(1, 0), cB + kstep, voffB); PG8_STAGE(PG8_SA(1, 0), cA + kstep, vA[0]); PG8_STAGE(PG8_SB(1, 1), cB + hstepB + kstep, voffB);
    PG8_WAIT_V(6); PG8_BAR;
    for (;;) {
        const bool has_next = P.next(ui + 1, nxt);
        const char* nA = cA; const char* nB = cB;
#pragma unroll
        for (int h = 0; h < 2; ++h)
#pragma unroll
            for (int i = 0; i < 2; ++i) nvA[h][i] = vA[h][i];
        if (has_next) { nA = P.a_base(nxt); nB = P.b_base(nxt); P.a_offs(nxt, Rr, Cc, nvA); }
        for (int t = 0; t < nt; t += 2) {
            const bool last = (t == nt - 2);
            const char* a1 = cA + (size_t)(t + 1) * kstep;
            const char* a2 = last ? nA : cA + (size_t)(t + 2) * kstep; const char* b2 = last ? nB : cB + (size_t)(t + 2) * kstep;
            const char* a3 = a2 + kstep; const char* b3 = b2 + kstep;
            unsigned o2a[2], o2b[2];
#pragma unroll
            for (int i = 0; i < 2; ++i) { o2a[i] = last ? nvA[0][i] : vA[0][i]; o2b[i] = last ? nvA[1][i] : vA[1][i]; }
            PG8_LDB(B0, 0, 0); PG8_LDB(B1, 0, 1); PG8_SCHED; PG8_LDA(At, 0, 0); PG8_STAGE(PG8_SA(1, 1), a1, vA[1]);
            PG8_WAIT_V(8); PG8_WAIT_L(0); PG8_BAR; PG8_MMA(0, 0, At, B0); PG8_MMA(0, 1, At, B1); PG8_BAR; PG8_SCHED;
            PG8_LDA(At, 0, 1); PG8_STAGE(PG8_SB(0, 0), b2, voffB); PG8_STAGE(PG8_SB(0, 1), b2 + hstepB, voffB); PG8_STAGE(PG8_SA(0, 0), a2, o2a);
            PG8_WAIT_V(8); PG8_WAIT_L(0); PG8_BAR; PG8_MMA(1, 0, At, B0); PG8_MMA(1, 1, At, B1); PG8_BAR; PG8_SCHED;
            PG8_LDB(B0, 1, 0); PG8_LDB(B1, 1, 1); PG8_SCHED; PG8_LDA(At, 1, 0); PG8_STAGE(PG8_SA(0, 1), a2, o2b);
            PG8_WAIT_V(8); PG8_WAIT_L(0); PG8_BAR; PG8_MMA(0, 0, At, B0); PG8_MMA(0, 1, At, B1); PG8_BAR; PG8_SCHED;
            PG8_LDA(At, 1, 1); PG8_STAGE(PG8_SB(1, 0), b3, voffB); PG8_STAGE(PG8_SB(1, 1), b3 + hstepB, voffB); PG8_STAGE(PG8_SA(1, 0), a3, o2a);
            PG8_WAIT_V(8); PG8_WAIT_L(0); PG8_BAR; PG8_MMA(1, 0, At, B0); PG8_MMA(1, 1, At, B1); PG8_BAR; PG8_SCHED;
        }
        if constexpr (ALIGN_EPI) { if (wr == 0) PG8_BAR; }
        if constexpr (!Epi::AFTER_DRAIN) { E(acc, cur, wr, wc, fr, fq); }
        if (!has_next) break;
#pragma unroll
        for (int a = 0; a < 2; ++a)
#pragma unroll
            for (int b = 0; b < 2; ++b)
#pragma unroll
                for (int m = 0; m < 4; ++m)
#pragma unroll
                    for (int n = 0; n < 2; ++n) acc[a][b][m][n] = (f32x4){0.f, 0.f, 0.f, 0.f};
        cur = nxt; cA = nA; cB = nB; ++ui;
#pragma unroll
        for (int h = 0; h < 2; ++h)
#pragma unroll
            for (int i = 0; i < 2; ++i) vA[h][i] = nvA[h][i];
        if constexpr (ALIGN_EPI) { if (wr == 1) PG8_BAR; }
    }
    PG8_WAIT_V(0);
    if constexpr (!ALIGN_EPI) { if (wr == 0) PG8_BAR; }
    PG8_BAR;
    if constexpr (Epi::AFTER_DRAIN) { E.fused(acc, cur, wr, wc, fr, fq, lds, wid, lane); }
#undef PG8_SA
#undef PG8_SB
#undef PG8_STAGE
#undef PG8_LDA
#undef PG8_LDB
#undef PG8_MMA
#undef PG8_WAIT_V
#undef PG8_WAIT_L
#undef PG8_BAR
#undef PG8_SCHED
}
}

constexpr int NWAVES = 8;
struct Args {
    const float* in[25]; float* out; unsigned char* ws; int ph_lo, ph_hi;
};
static_assert(sizeof(Args) == 224, "Args layout (kernarg offsets in ka_ptr users)");
struct Frame {
    lds_u8* lds; volatile LAS unsigned* MISC; gu32* ctl;
    int tid, lane, wave, G, bid;
};
__device__ __forceinline__ void relaunder(Frame& F) { int t = threadIdx.x; asm volatile("" : "+v"(t)); F.tid = t; F.lane = t & 63; F.wave = __builtin_amdgcn_readfirstlane(t >> 6); int b = blockIdx.x; asm volatile("" : "+s"(b)); F.bid = b; }


typedef const unsigned char* cptr_t;
__device__ __forceinline__ cptr_t ka_ptr(int off) { const __attribute__((address_space(4))) unsigned char* p = (const __attribute__((address_space(4))) unsigned char*)__builtin_amdgcn_kernarg_segment_ptr(); asm volatile("" : "+s"(p)); return *(const __attribute__((address_space(4))) cptr_t*)(p + off); }
#define INP(i) ((const float*)ka_ptr(8 * (i)))
#define OUTP ((float*)ka_ptr(200))
#define WSP ((unsigned char*)ka_ptr(208))

struct Row { f32x4 v[8]; };
__device__ __forceinline__ void row_load_f32(Row& r, const float* p, int lane) {
#pragma unroll
    for (int j = 0; j < 4; ++j) { const f32x4* q = (const f32x4*)(p + 512 * j + 8 * lane); r.v[2 * j] = q[0]; r.v[2 * j + 1] = q[1]; }
}
__device__ __forceinline__ void row_store_f32(const Row& r, float* p, int lane) {
#pragma unroll
    for (int j = 0; j < 4; ++j) { f32x4* q = (f32x4*)(p + 512 * j + 8 * lane); q[0] = r.v[2 * j]; q[1] = r.v[2 * j + 1]; }
}
__device__ __forceinline__ void row_store_bf16(const Row& r, bf16* p, int lane) {
#pragma unroll
    for (int j = 0; j < 4; ++j) { const f32x4 a = r.v[2 * j], b = r.v[2 * j + 1]; u32x4 w; w.x = cvt_pk_bf16(a[0], a[1]); w.y = cvt_pk_bf16(a[2], a[3]); w.z = cvt_pk_bf16(b[0], b[1]); w.w = cvt_pk_bf16(b[2], b[3]);
        *(u32x4*)(p + 512 * j + 8 * lane) = w; }
}
__device__ __forceinline__ void row_add_bf16(Row& r, const bf16* p, int lane) {
#pragma unroll
    for (int j = 0; j < 4; ++j) { const u32x4 w = *(const u32x4*)(p + 512 * j + 8 * lane);
        r.v[2 * j] += (f32x4){bf_lo(w.x), bf_hi(w.x), bf_lo(w.y), bf_hi(w.y)}; r.v[2 * j + 1] += (f32x4){bf_lo(w.z), bf_hi(w.z), bf_lo(w.w), bf_hi(w.w)}; }
}
__device__ __forceinline__ void row_layernorm(Row& r, const Row& g, const Row& b) {
    float s = 0.f;
#pragma unroll
    for (int i = 0; i < 8; ++i) s += (r.v[i][0] + r.v[i][1]) + (r.v[i][2] + r.v[i][3]);
    const float mean = wave_sum(s) * (1.0f / D); float s2 = 0.f;
#pragma unroll
    for (int i = 0; i < 8; ++i) { r.v[i] = r.v[i] - mean; s2 += (r.v[i][0] * r.v[i][0] + r.v[i][1] * r.v[i][1]) + (r.v[i][2] * r.v[i][2] + r.v[i][3] * r.v[i][3]); }
    const float rstd = 1.0f / sqrtf(wave_sum(s2) * (1.0f / D) + LN_EPS);
#pragma unroll
    for (int i = 0; i < 8; ++i) r.v[i] = r.v[i] * rstd * g.v[i] + b.v[i];
}

__device__ __forceinline__ void tr_item(const float* W, int N, int k0, int n0, bf16* WT, size_t orow0, int K, LAS float* scr, int lane) {
    f32x4 v[16];
#pragma unroll
    for (int i = 0; i < 16; ++i) v[i] = *(const f32x4*)(W + (size_t)(k0 + 4 * i + (lane >> 4)) * N + n0 + 4 * (lane & 15));
#pragma unroll
    for (int i = 0; i < 16; ++i) { LAS float* s = scr + (4 * i + (lane >> 4)) * 65 + 4 * (lane & 15); s[0] = v[i][0]; s[1] = v[i][1]; s[2] = v[i][2]; s[3] = v[i][3]; }
    LDS_WAIT(); asm volatile("" ::: "memory");
    const int c = lane >> 3;
#pragma unroll
    for (int p = 0; p < 8; ++p) { const int n = 8 * p + (lane & 7); const LAS float* s = scr + (8 * c) * 65 + n;
        u32x4 o; o.x = cvt_pk_bf16(s[0 * 65], s[1 * 65]); o.y = cvt_pk_bf16(s[2 * 65], s[3 * 65]); o.z = cvt_pk_bf16(s[4 * 65], s[5 * 65]); o.w = cvt_pk_bf16(s[6 * 65], s[7 * 65]);
        *(u32x4*)(WT + (orow0 + n) * (size_t)K + k0 + 8 * c) = o; }
    LDS_WAIT(); asm volatile("" ::: "memory");
}
template <bool GU> __device__ __forceinline__ void tr_matrix_item(const float* W, int K, int N, bf16* WT, size_t orow_base, int item, LAS float* scr, int lane) {
    const int nblk = N / 64, kb = item / nblk, nb = item % nblk, n0 = nb * 64;
    const size_t orow0 = orow_base + (GU ? (size_t)((n0 >> 7) * 256 + (n0 & 127)) : (size_t)n0);
    tr_item(W, N, kb * 64, n0, WT, orow0, K, scr, lane);
}

constexpr int ATT_ROWB = 160;
constexpr int ATT_TILE = 272 * ATT_ROWB;
typedef short v4i16_t __attribute__((ext_vector_type(4)));
__device__ __forceinline__ s16x4 vtr(const lds_u8* p) { return __builtin_bit_cast(s16x4, __builtin_amdgcn_ds_read_tr16_b64_v4i16((LAS v4i16_t*)p)); }
__device__ __forceinline__ void attn_phase(Frame& F, const bf16* proj, const float* sinks, bf16* oA, bf16* oB, float* lseB) {
    lds_u8* Kt = F.lds; lds_u8* Vt = F.lds + ATT_TILE;
    const int tid = F.tid, wid = F.wave, lane = F.lane, fr = lane & 15, fq = lane >> 4;
    for (int i = tid; i < 2 * 640; i += NWAVES * 64) { lds_u8* base = (i >= 640) ? Vt : Kt; *(LAS unsigned*)(base + 256 * ATT_ROWB + (i % 640) * 4) = 0u; }
    __syncthreads();
    for (int u = F.bid; u < 8192; u += F.G) {
        const int kind = u >> 11, rem = u & 2047, b = rem >> 9, h = (rem >> 5) & 15, j32 = rem & 31;
        const int dsh = (kind <= 1) ? 0 : (kind == 2 ? 2 : 4), d = 1 << dsh, nbpr = 32 >> dsh, r = j32 / nbpr, nb = j32 % nbpr;
        const int qcol = (kind == 0) ? h * 64 : 1280 + h * 64, kcol = (kind == 0) ? 1024 + (h >> 3) * 64 : 2304 + h * 64, vcol = (kind == 0) ? 1152 + (h >> 3) * 64 : 3328 + h * 64;
        const int max_off = (kind == 0) ? 127 : 128;
        const float slope2 = __builtin_amdgcn_exp2f(-0.5f * (float)(h + 1)) * (float)d * LOG2E;
        const float sink2 = (kind == 0) ? sinks[h] * LOG2E : -__builtin_inff();
        const size_t tok0 = (size_t)b * SEQ + r;
#pragma unroll
        for (int i = 0; i < 4; ++i) { const int row = (tid >> 3) + 64 * i, c = tid & 7; int t = (nb - 1) * 128 + row; t = t < 0 ? 0 : t;
            const bf16* src = proj + (tok0 + (size_t)d * t) * INW + c * 8;
            const u32x4 kv = *(const u32x4*)(src + kcol), vv = *(const u32x4*)(src + vcol);
            *(LAS u32x4*)(Kt + row * ATT_ROWB + c * 16) = kv; *(LAS u32x4*)(Vt + row * ATT_ROWB + c * 16) = vv; }
        const int tq = nb * 128 + wid * 16 + fr; const size_t tokq = tok0 + (size_t)d * tq;
        const bf16x8 q0 = *(const bf16x8*)(proj + tokq * INW + qcol + 8 * fq), q1 = *(const bf16x8*)(proj + tokq * INW + qcol + 32 + 8 * fq);
        __syncthreads();
        f32x4 s[9];
#pragma unroll
        for (int j = 0; j < 9; ++j) { const lds_u8* kp = Kt + (16 * (wid + j) + fr) * ATT_ROWB + fq * 16;
            const bf16x8 a0 = *(const LAS bf16x8*)kp, a1 = *(const LAS bf16x8*)(kp + 64);
            f32x4 z = (f32x4){0.f, 0.f, 0.f, 0.f}; z = __builtin_amdgcn_mfma_f32_16x16x32_bf16(a0, q0, z, 0, 0, 0); s[j] = __builtin_amdgcn_mfma_f32_16x16x32_bf16(a1, q1, z, 0, 0, 0); }
        float mx = -__builtin_inff();
#pragma unroll
        for (int j = 0; j < 9; ++j)
#pragma unroll
            for (int e = 0; e < 4; ++e) { const int delta = 128 + fr - 16 * j - 4 * fq - e; const int tk = (nb - 1) * 128 + 16 * (wid + j) + 4 * fq + e;
                const bool valid = (delta >= 0) && (delta <= max_off) && (tk >= 0);
                const float v = valid ? (s[j][e] * (0.125f * LOG2E) - slope2 * (float)delta) : -__builtin_inff(); s[j][e] = v; mx = fmaxf(mx, v); }
        mx = fmaxf(mx, __shfl_xor(mx, 16)); mx = fmaxf(mx, __shfl_xor(mx, 32)); mx = fmaxf(mx, sink2);
        float sum = 0.f;
#pragma unroll
        for (int j = 0; j < 9; ++j)
#pragma unroll
            for (int e = 0; e < 4; ++e) { const float p = __builtin_amdgcn_exp2f(s[j][e] - mx); s[j][e] = p; sum += p; }
        sum += __shfl_xor(sum, 16); sum += __shfl_xor(sum, 32); sum += __builtin_amdgcn_exp2f(sink2 - mx);
        bf16x8 pb[5];
#pragma unroll
        for (int ks = 0; ks < 5; ++ks) { u32x4 w; w.x = cvt_pk_bf16(s[2 * ks][0], s[2 * ks][1]); w.y = cvt_pk_bf16(s[2 * ks][2], s[2 * ks][3]);
            if (ks < 4) { w.z = cvt_pk_bf16(s[2 * ks + 1][0], s[2 * ks + 1][1]); w.w = cvt_pk_bf16(s[2 * ks + 1][2], s[2 * ks + 1][3]); } else { w.z = 0u; w.w = 0u; }
            pb[ks] = __builtin_bit_cast(bf16x8, w); }
        f32x4 o[4];
#pragma unroll
        for (int dt = 0; dt < 4; ++dt) { f32x4 z = (f32x4){0.f, 0.f, 0.f, 0.f};
#pragma unroll
            for (int ks = 0; ks < 5; ++ks) { const lds_u8* vp = Vt + (16 * (wid + 2 * ks) + 4 * fq + (fr >> 2)) * ATT_ROWB + (16 * dt + 4 * (fr & 3)) * 2;
                const s16x4 v0 = vtr(vp), v1 = vtr(vp + 16 * ATT_ROWB);
                const bf16x8 a = (bf16x8){v0[0], v0[1], v0[2], v0[3], v1[0], v1[1], v1[2], v1[3]};
                z = __builtin_amdgcn_mfma_f32_16x16x32_bf16(a, pb[ks], z, 0, 0, 0); }
            o[dt] = z; }
        const float inv = 1.0f / sum;
        bf16* orow = ((kind == 0) ? oA : oB + (size_t)(kind - 1) * M * 1024) + tokq * 1024 + h * 64 + 4 * fq;
#pragma unroll
        for (int dt = 0; dt < 4; ++dt) { u32x2 w; w.x = cvt_pk_bf16(o[dt][0] * inv, o[dt][1] * inv); w.y = cvt_pk_bf16(o[dt][2] * inv, o[dt][3] * inv); *(u32x2*)(orow + 16 * dt) = w; }
        if (kind > 0 && fq == 0) lseB[((size_t)(kind - 1) * M + tokq) * 16 + h] = mx + __builtin_amdgcn_logf(sum);
        __syncthreads();
    }
}

__device__ __forceinline__ void merge_phase(Frame& F, const bf16* oA, const bf16* oB, const float* lseB, const float* ga, const float* gb, bf16* mixed) {
    const int lane = F.lane, gw = F.bid * NWAVES + F.wave, NGW = F.G * NWAVES;
    f32x4 gA[4], gB[4];
#pragma unroll
    for (int jj = 0; jj < 2; ++jj) { gA[2 * jj] = *(const f32x4*)(ga + 512 * jj + 8 * lane); gA[2 * jj + 1] = *(const f32x4*)(ga + 512 * jj + 8 * lane + 4);
        gB[2 * jj] = *(const f32x4*)(gb + 512 * jj + 8 * lane); gB[2 * jj + 1] = *(const f32x4*)(gb + 512 * jj + 8 * lane + 4); }
    for (int t = gw; t < M; t += NGW) {
        f32x4 a[4], bb[4];
        float ssa = 0.f, ssb = 0.f;
#pragma unroll
        for (int jj = 0; jj < 2; ++jj) {
            const int e0 = 512 * jj + 8 * lane, hh = e0 >> 6;
            const u32x4 w = *(const u32x4*)(oA + (size_t)t * 1024 + e0);
            a[2 * jj] = (f32x4){bf_lo(w.x), bf_hi(w.x), bf_lo(w.y), bf_hi(w.y)}; a[2 * jj + 1] = (f32x4){bf_lo(w.z), bf_hi(w.z), bf_lo(w.w), bf_hi(w.w)};
            float l0 = lseB[((size_t)0 * M + t) * 16 + hh], l1 = lseB[((size_t)1 * M + t) * 16 + hh], l2 = lseB[((size_t)2 * M + t) * 16 + hh];
            const float lm = fmaxf(l0, fmaxf(l1, l2)); l0 = __builtin_amdgcn_exp2f(l0 - lm); l1 = __builtin_amdgcn_exp2f(l1 - lm); l2 = __builtin_amdgcn_exp2f(l2 - lm);
            const float li = 1.0f / (l0 + l1 + l2); l0 *= li; l1 *= li; l2 *= li;
            const u32x4 w0 = *(const u32x4*)(oB + ((size_t)0 * M + t) * 1024 + e0), w1 = *(const u32x4*)(oB + ((size_t)1 * M + t) * 1024 + e0), w2 = *(const u32x4*)(oB + ((size_t)2 * M + t) * 1024 + e0);
            bb[2 * jj] = (f32x4){bf_lo(w0.x), bf_hi(w0.x), bf_lo(w0.y), bf_hi(w0.y)} * l0 + (f32x4){bf_lo(w1.x), bf_hi(w1.x), bf_lo(w1.y), bf_hi(w1.y)} * l1 + (f32x4){bf_lo(w2.x), bf_hi(w2.x), bf_lo(w2.y), bf_hi(w2.y)} * l2;
            bb[2 * jj + 1] = (f32x4){bf_lo(w0.z), bf_hi(w0.z), bf_lo(w0.w), bf_hi(w0.w)} * l0 + (f32x4){bf_lo(w1.z), bf_hi(w1.z), bf_lo(w1.w), bf_hi(w1.w)} * l1 + (f32x4){bf_lo(w2.z), bf_hi(w2.z), bf_lo(w2.w), bf_hi(w2.w)} * l2;
        }
#pragma unroll
        for (int i = 0; i < 4; ++i) { ssa += (a[i][0] * a[i][0] + a[i][1] * a[i][1]) + (a[i][2] * a[i][2] + a[i][3] * a[i][3]); ssb += (bb[i][0] * bb[i][0] + bb[i][1] * bb[i][1]) + (bb[i][2] * bb[i][2] + bb[i][3] * bb[i][3]); }
        const float ra = 1.0f / sqrtf(wave_sum(ssa) * (1.0f / 1024.0f) + RMS_EPS), rb = 1.0f / sqrtf(wave_sum(ssb) * (1.0f / 1024.0f) + RMS_EPS);
#pragma unroll
        for (int jj = 0; jj < 2; ++jj) { const int e0 = 512 * jj + 8 * lane;
            const f32x4 x0 = a[2 * jj] * ra * gA[2 * jj], x1 = a[2 * jj + 1] * ra * gA[2 * jj + 1], y0 = bb[2 * jj] * rb * gB[2 * jj], y1 = bb[2 * jj + 1] * rb * gB[2 * jj + 1];
            u32x4 w; w.x = cvt_pk_bf16(x0[0], x0[1]); w.y = cvt_pk_bf16(x0[2], x0[3]); w.z = cvt_pk_bf16(x1[0], x1[1]); w.w = cvt_pk_bf16(x1[2], x1[3]);
            *(u32x4*)(mixed + (size_t)t * D + e0) = w;
            w.x = cvt_pk_bf16(y0[0], y0[1]); w.y = cvt_pk_bf16(y0[2], y0[3]); w.z = cvt_pk_bf16(y1[0], y1[1]); w.w = cvt_pk_bf16(y1[2], y1[3]);
            *(u32x4*)(mixed + (size_t)t * D + 1024 + e0) = w; }
    }
}

__device__ __forceinline__ void ln_phase(Frame& F, const float* y, const float* g, const float* b, float* hout, bf16* hb) {
    const int lane = F.lane, gw = F.bid * NWAVES + F.wave, NGW = F.G * NWAVES;
    Row rg, rb; row_load_f32(rg, g, lane); row_load_f32(rb, b, lane);
    for (int t = gw; t < M; t += NGW) { Row r; row_load_f32(r, y + (size_t)t * D, lane); row_layernorm(r, rg, rb); row_store_f32(r, hout + (size_t)t * D, lane); if (hb) row_store_bf16(r, hb + (size_t)t * D, lane); }
}

__device__ __forceinline__ void router_phase(Frame& F, const float* h, const float* wr_, const float* rbias, gu32* cnt, int* tok_e, int* tok_slot, float* tok_gate, int* row_tok, float* row_gate) {
    const int tid = F.tid, wid = F.wave, lane = F.lane, fr = lane & 15, fq = lane >> 4;
    LAS float* sc = (LAS float*)F.lds;
    LAS int* lcnt = (LAS int*)(F.lds + 17408);
    LAS int* gbase = (LAS int*)(F.lds + 17408 + 256);
    LAS int* ti_e = (LAS int*)(F.lds + 18432);
    LAS int* ti_ls = (LAS int*)(F.lds + 18432 + 2048);
    LAS float* ti_g = (LAS float*)(F.lds + 18432 + 4096);
    for (int i = F.bid * NWAVES * 64 + tid; i < NROWS; i += F.G * NWAVES * 64) { const bool sh = i >= RB_SHARED0 * 256; row_tok[i] = sh ? i - RB_SHARED0 * 256 : 0; row_gate[i] = sh ? 1.0f : 0.0f; }
    for (int grp = F.bid; grp < M / 64; grp += F.G) {
        if (tid < 64) lcnt[tid] = 0;
        if (wid < 4) {
            f32x4 acc[4];
#pragma unroll
            for (int n = 0; n < 4; ++n) acc[n] = (f32x4){0.f, 0.f, 0.f, 0.f};
            const float* xrow = h + (size_t)(grp * 64 + wid * 16 + fr) * D + 4 * fq;
#pragma unroll 2
            for (int kb = 0; kb < D; kb += 16) {
                const f32x4 a = *(const f32x4*)(xrow + kb);
#pragma unroll
                for (int s = 0; s < 4; ++s) { const f32x4 bq = *(const f32x4*)(wr_ + (size_t)(kb + 4 * fq + s) * NE + 4 * fr);
#pragma unroll
                    for (int n = 0; n < 4; ++n) acc[n] = __builtin_amdgcn_mfma_f32_16x16x4f32(a[s], bq[n], acc[n], 0, 0, 0); }
            }
#pragma unroll
            for (int n = 0; n < 4; ++n)
#pragma unroll
                for (int e = 0; e < 4; ++e) sc[(wid * 16 + 4 * fq + e) * 65 + 4 * fr + n] = acc[n][e];
        }
        __syncthreads();
        const float bias = rbias[lane];
        for (int ti = 0; ti < 8; ++ti) {
            const int tl = wid * 8 + ti;
            const float logit = sc[tl * 65 + lane];
            const float score = 1.0f / (1.0f + __expf(-logit));
            const float selv = score + bias;
            float m1 = selv;
#pragma unroll
            for (int o = 1; o < 8; o <<= 1) m1 = fmaxf(m1, __shfl_xor(m1, o));
            int i1 = (selv == m1) ? lane : 64;
#pragma unroll
            for (int o = 1; o < 8; o <<= 1) { const int x = __shfl_xor(i1, o); i1 = x < i1 ? x : i1; }
            float m2 = (lane == i1) ? -__builtin_inff() : selv;
#pragma unroll
            for (int o = 1; o < 8; o <<= 1) m2 = fmaxf(m2, __shfl_xor(m2, o));
            const float gs = m1 + m2; const int gi = lane >> 3;
            int rg = 0;
#pragma unroll
            for (int j = 0; j < 8; ++j) { const float og = __shfl(gs, 8 * j); rg += ((og > gs) || (og == gs && j < gi)) ? 1 : 0; }
            const bool gsel = rg < 4;
            const float mv = gsel ? selv : -__builtin_inff();
            int rk = 0;
#pragma unroll 4
            for (int j = 0; j < 64; ++j) { const float ov = __shfl(mv, j); rk += ((ov > mv) || (ov == mv && j < lane)) ? 1 : 0; }
            const bool chosen = gsel && (rk < TOPK);
            const float ssum = wave_sum(chosen ? score : 0.0f);
            if (chosen) { const int ls = __hip_atomic_fetch_add(lcnt + lane, 1, __ATOMIC_RELAXED, __HIP_MEMORY_SCOPE_WORKGROUP); ti_e[tl * 8 + rk] = lane; ti_ls[tl * 8 + rk] = ls; ti_g[tl * 8 + rk] = score / ssum * 2.5f; }
        }
        __syncthreads();
        if (tid < 64) gbase[tid] = (int)__hip_atomic_fetch_add((unsigned*)(cnt + tid), (unsigned)lcnt[tid], RLX_AGENT);
        __syncthreads();
        { const int e = ti_e[tid]; const size_t gi = (size_t)grp * 512 + tid; tok_e[gi] = e; tok_slot[gi] = gbase[e] + ti_ls[tid]; tok_gate[gi] = ti_g[tid]; }
        __syncthreads();
    }
}

__device__ __forceinline__ void scatter_phase(Frame& F, const gu32* cnt, const int* tok_e, const int* tok_slot, const float* tok_gate, int* tok_pos, int* row_tok, float* row_gate, int* meta) {
    LAS int* pstart = (LAS int*)F.lds;
    if (F.tid == 0) { int acc = 0; for (int e = 0; e < NE; ++e) { pstart[e] = acc; const int c = (int)__hip_atomic_load(cnt + e, RLX_AGENT); acc += (c + 255) >> 8; } pstart[NE] = acc; }
    __syncthreads();
    if (F.bid == 0) {
        if (F.tid == 0) meta[0] = pstart[NE];
        if (F.tid < NE) { for (int b = pstart[F.tid]; b < pstart[F.tid + 1]; ++b) meta[16 + b] = F.tid; }
    }
    for (int i = F.bid * NWAVES * 64 + F.tid; i < M * TOPK; i += F.G * NWAVES * 64) {
        const int e = tok_e[i], pos = pstart[e] * 256 + tok_slot[i];
        row_tok[pos] = i >> 3; row_gate[pos] = tok_gate[i]; tok_pos[i] = pos;
    }
}

__device__ __forceinline__ void combine_phase(Frame& F, const float* hres, const bf16* yrows, const int* tok_pos, const float* g, const float* b, float* hout, bf16* hb) {
    const int lane = F.lane, gw = F.bid * NWAVES + F.wave, NGW = F.G * NWAVES;
    Row rg, rb; row_load_f32(rg, g, lane); row_load_f32(rb, b, lane);
    for (int t = gw; t < M; t += NGW) {
        Row r; row_load_f32(r, hres + (size_t)t * D, lane);
#pragma unroll
        for (int i = 0; i < 8; ++i) r.v[i] = r.v[i] * ALPHA;
        int pos[8];
#pragma unroll
        for (int k = 0; k < 8; ++k) pos[k] = tok_pos[(size_t)t * 8 + k];
#pragma unroll
        for (int k = 0; k < 8; ++k) row_add_bf16(r, yrows + (size_t)pos[k] * D, lane);
        row_add_bf16(r, yrows + (size_t)(RB_SHARED0 * 256 + t) * D, lane);
        row_layernorm(r, rg, rb);
        row_store_f32(r, hout + (size_t)t * D, lane); if (hb) row_store_bf16(r, hb + (size_t)t * D, lane);
    }
}

constexpr int NPH_LAYER = 16, NPH = 2 + DEPTH * NPH_LAYER;
constexpr size_t SZ_WIN = (size_t)D * INW, SZ_DD = (size_t)D * D, SZ_EXP = (size_t)D * DE;

__global__ void __launch_bounds__(NWAVES * 64, 2) mk_fwd(Args args) {
    extern __shared__ __attribute__((aligned(16))) unsigned char lds_raw[];
    Frame F;
    F.lds = (lds_u8*)lds_raw; F.MISC = (volatile LAS unsigned*)(F.lds + MISC_OFF);
    F.tid = threadIdx.x; F.lane = F.tid & 63; F.wave = __builtin_amdgcn_readfirstlane(F.tid >> 6); F.G = gridDim.x; F.bid = blockIdx.x;
    F.ctl = (gu32*)(WSP + WS_CTL);
    if (F.tid < 64) F.MISC[F.tid] = 0u;
    __syncthreads();
    const int lo = args.ph_lo, hi = args.ph_hi;
    const bool use_bar = (hi - lo) > 1;
    XcdBarrier bar; bar.bar = (unsigned*)(F.ctl + CW_BAR); bar.x = 0; bar.st = nullptr;
    if (use_bar) bar = xcd_barrier_post((unsigned*)(F.ctl + CW_BAR), F.MISC + 8);
#define IN(k) (lo <= (k) && (k) < hi)
#define SEAM(k) do { if (IN(k) && IN((k) + 1)) xcd_barrier(bar); } while (0)

#define xin ((const float*)INP(0))
#define memb ((bf16*)(WSP + WS_MEMB))
#define Kc ((bf16*)(WSP + WS_KC))
#define VT ((bf16*)(WSP + WS_VT))
#define WinT ((bf16*)(WSP + WS_WIN))
#define WoutT ((bf16*)(WSP + WS_WOUT))
#define WqT ((bf16*)(WSP + WS_WQ))
#define WoT ((bf16*)(WSP + WS_WO))
#define WguT ((bf16*)(WSP + WS_WGU))
#define WdT ((bf16*)(WSP + WS_WD))
#define hbuf ((float*)(WSP + WS_H))
#define hb ((bf16*)(WSP + WS_HB))
#define ybuf ((float*)(WSP + WS_Y))
#define proj ((bf16*)(WSP + WS_PROJ))
#define oA ((bf16*)(WSP + WS_OA))
#define oB ((bf16*)(WSP + WS_OB))
#define lseB ((float*)(WSP + WS_LSE))
#define mixed ((bf16*)(WSP + WS_MIXED))
#define qb ((bf16*)(WSP + WS_Q))
#define Pb ((bf16*)(WSP + WS_P))
#define ob ((bf16*)(WSP + WS_O))
#define WkT ((bf16*)(WSP + WS_WKT))
#define WvT ((bf16*)(WSP + WS_WVT))
#define hid ((bf16*)(WSP + WS_HID))
#define yrows ((bf16*)(WSP + WS_YROWS))
#define meta ((int*)(WSP + WS_META))
#define tok_e ((int*)(WSP + WS_TOKE))
#define tok_slot ((int*)(WSP + WS_TOKSLOT))
#define tok_gate ((float*)(WSP + WS_TOKGATE))
#define tok_pos ((int*)(WSP + WS_TOKPOS))
#define row_tok ((int*)(WSP + WS_ROWTOK))
#define row_gate ((float*)(WSP + WS_ROWGATE))

    if (KIND_EN(0) && IN(0)) { relaunder(F);
        const int gw = F.bid * NWAVES + F.wave, NGW = F.G * NWAVES; LAS float* scr = (LAS float*)(F.lds + F.wave * 16640);
        { const float* xp = xin; bf16* hbp = hb;
        for (size_t i = (size_t)F.bid * NWAVES * 64 + F.tid; i < (size_t)M * D / 8; i += (size_t)F.G * NWAVES * 64) {
            const f32x4 a = *(const f32x4*)(xp + i * 8), b = *(const f32x4*)(xp + i * 8 + 4);
            u32x4 w; w.x = cvt_pk_bf16(a[0], a[1]); w.y = cvt_pk_bf16(a[2], a[3]); w.z = cvt_pk_bf16(b[0], b[1]); w.w = cvt_pk_bf16(b[2], b[3]); *(u32x4*)(hbp + i * 8) = w; } }
        { const float* mem = INP(1); bf16* mb = memb;
        for (size_t i = (size_t)F.bid * NWAVES * 64 + F.tid; i < (size_t)NBATCH * 256 * D / 8; i += (size_t)F.G * NWAVES * 64) {
            const f32x4 a = *(const f32x4*)(mem + i * 8), b = *(const f32x4*)(mem + i * 8 + 4);
            u32x4 w; w.x = cvt_pk_bf16(a[0], a[1]); w.y = cvt_pk_bf16(a[2], a[3]); w.z = cvt_pk_bf16(b[0], b[1]); w.w = cvt_pk_bf16(b[2], b[3]); *(u32x4*)(mb + i * 8) = w; } }
        { const float* wk = INP(10); const float* wv = INP(11); bf16* wkt = WkT; bf16* wvt = WvT;
        for (int it = gw; it < 4096; it += NGW) { const int mat = it >> 10, sub = it & 1023, l = mat & 1;
            const float* W = (mat < 2 ? wk : wv) + (size_t)l * SZ_DD;
            tr_matrix_item<false>(W, D, D, mat < 2 ? wkt : wvt, (size_t)l * D, sub, scr, F.lane); } }
    }
    SEAM(0);
    if (KIND_EN(1) && IN(1)) { relaunder(F);
        { pg8::ProbStatic P{(const char*)memb, (const char*)WkT, D, D, D, (size_t)256 * D * 2, 0, 0, (size_t)256 * D * 2, 0, 1, {}}; P.S.init(4, 16, F.G, F.bid);
          pg8::EpiBf16 E{Kc, 2 * D, 1.0f}; pg8::gemm_phase<pg8::EpiBf16, pg8::ProbStatic, false>(F.lds, P, E, F.tid); }
        { pg8::ProbStatic P{(const char*)WvT, (const char*)memb, D, D, D, (size_t)256 * D * 2, 0, 0, (size_t)256 * D * 2, 0, 1, {}}; P.S.init(16, 4, F.G, (F.bid + F.G / 2) % F.G);
          pg8::EpiBf16 E{VT, 1024, 1.0f}; pg8::gemm_phase<pg8::EpiBf16, pg8::ProbStatic, false>(F.lds, P, E, F.tid); }
    }
    SEAM(1);

    for (int l = 0; l < DEPTH; ++l) {
        const int pb = 2 + NPH_LAYER * l;
        const float* hres = (l == 0) ? xin : hbuf;
        if (KIND_EN(2) && IN(pb + 0)) { relaunder(F);
            const int gw = F.bid * NWAVES + F.wave, NGW = F.G * NWAVES; LAS float* scr = (LAS float*)(F.lds + F.wave * 16640);
            const float* w_in = INP(2) + (size_t)l * SZ_WIN; const float* w_out = INP(6) + (size_t)l * SZ_DD;
            const float* wq = INP(9) + (size_t)l * SZ_DD; const float* wo = INP(12) + (size_t)l * SZ_DD;
            const float* wg = INP(17) + (size_t)l * NE * SZ_EXP; const float* wu = INP(18) + (size_t)l * NE * SZ_EXP; const float* wd = INP(19) + (size_t)l * NE * SZ_EXP;
            const float* wsg = INP(20) + (size_t)l * SZ_EXP; const float* wsu = INP(21) + (size_t)l * SZ_EXP; const float* wsd = INP(22) + (size_t)l * SZ_EXP;
            bf16* pWin = WinT; bf16* pWout = WoutT; bf16* pWq = WqT; bf16* pWo = WoT; bf16* pWgu = WguT; bf16* pWd = WdT;
            constexpr int I_IN = 32 * 68, I_DD = 1024, I_E = 256, NIT = I_IN + 3 * I_DD + 3 * 65 * I_E;
            for (int it = gw; it < NIT; it += NGW) {
                int r = it;
                if (r < I_IN) { tr_matrix_item<false>(w_in, D, INW, pWin, 0, r, scr, F.lane); continue; } r -= I_IN;
                if (r < I_DD) { tr_matrix_item<false>(w_out, D, D, pWout, 0, r, scr, F.lane); continue; } r -= I_DD;
                if (r < I_DD) { tr_matrix_item<false>(wq, D, D, pWq, 0, r, scr, F.lane); continue; } r -= I_DD;
                if (r < I_DD) { tr_matrix_item<false>(wo, D, D, pWo, 0, r, scr, F.lane); continue; } r -= I_DD;
                if (r < 65 * I_E) { const int e = r >> 8; tr_matrix_item<true>(e < NE ? wg + (size_t)e * SZ_EXP : wsg, D, DE, pWgu + (size_t)e * 1024 * D, 0, r & 255, scr, F.lane); continue; } r -= 65 * I_E;
                if (r < 65 * I_E) { const int e = r >> 8; tr_matrix_item<true>(e < NE ? wu + (size_t)e * SZ_EXP : wsu, D, DE, pWgu + (size_t)e * 1024 * D, 128, r & 255, scr, F.lane); continue; } r -= 65 * I_E;
                { const int e = r >> 8; tr_matrix_item<false>(e < NE ? wd + (size_t)e * SZ_EXP : wsd, DE, D, pWd + (size_t)e * D * DE, 0, r & 255, scr, F.lane); }
            }
        }
        SEAM(pb + 0);
        if (KIND_EN(3) && IN(pb + 1)) { relaunder(F);
            pg8::ProbStatic P{(const char*)hb, (const char*)WinT, D, D, D, (size_t)256 * D * 2, 0, 0, (size_t)256 * D * 2, 0, 1, {}}; P.S.init(M / 256, INW / 256, F.G, F.bid);
            pg8::EpiBf16 E{proj, INW, 1.0f}; pg8::gemm_phase<pg8::EpiBf16, pg8::ProbStatic, true>(F.lds, P, E, F.tid);
        }
        SEAM(pb + 1);
        if (KIND_EN(4) && IN(pb + 2)) { relaunder(F); attn_phase(F, proj, INP(3) + l * 16, oA, oB, lseB); }
        SEAM(pb + 2);
        if (KIND_EN(5) && IN(pb + 3)) { relaunder(F); merge_phase(F, oA, oB, lseB, INP(4) + l * 1024, INP(5) + l * 1024, mixed); }
        SEAM(pb + 3);
        if (KIND_EN(6) && IN(pb + 4)) { relaunder(F);
            pg8::ProbStatic P{(const char*)mixed, (const char*)WoutT, D, D, D, (size_t)256 * D * 2, 0, 0, (size_t)256 * D * 2, 0, 1, {}}; P.S.init(M / 256, D / 256, F.G, F.bid);
            pg8::EpiResF32 E{hres, ybuf, D, ALPHA}; pg8::gemm_phase<pg8::EpiResF32, pg8::ProbStatic, true>(F.lds, P, E, F.tid);
        }
        SEAM(pb + 4);
        if (KIND_EN(7) && IN(pb + 5)) { relaunder(F); ln_phase(F, ybuf, INP(7) + l * D, INP(8) + l * D, hbuf, hb); }
        SEAM(pb + 5);
        if (KIND_EN(8) && IN(pb + 6)) { relaunder(F);
            pg8::ProbStatic P{(const char*)hb, (const char*)WqT, D, D, D, (size_t)256 * D * 2, 0, 0, (size_t)256 * D * 2, 0, 1, {}}; P.S.init(M / 256, D / 256, F.G, F.bid);
            pg8::EpiBf16 E{qb, D, 1.0f}; pg8::gemm_phase<pg8::EpiBf16, pg8::ProbStatic, true>(F.lds, P, E, F.tid);
        }
        SEAM(pb + 6);
        if (KIND_EN(9) && IN(pb + 7)) { relaunder(F);
            pg8::ProbStatic P{(const char*)qb, (const char*)(Kc + (size_t)l * D), D, 2 * D, 512, (size_t)256 * D * 2, (size_t)512 * 2, 0, (size_t)512 * 2, (size_t)256 * 2 * D * 2, 16, {}}; P.S.init(M / 256, 4, F.G, F.bid);
            pg8::EpiSoftmax E{Pb, 1024, 0.044194173824159216f * LOG2E}; pg8::gemm_phase<pg8::EpiSoftmax, pg8::ProbStatic, false>(F.lds, P, E, F.tid);
        }
        SEAM(pb + 7);
        if (KIND_EN(10) && IN(pb + 8)) { relaunder(F);
            pg8::ProbStatic P{(const char*)Pb, (const char*)(VT + (size_t)l * D * 1024), 1024, 1024, 256, (size_t)256 * 1024 * 2, (size_t)256 * 2, 1, (size_t)256 * 1024 * 2, (size_t)256 * 2, 16, {}}; P.S.init(M / 256, 8, F.G, F.bid);
            pg8::EpiBf16 E{ob, D, 1.0f}; pg8::gemm_phase<pg8::EpiBf16, pg8::ProbStatic, true>(F.lds, P, E, F.tid);
        }
        SEAM(pb + 8);
        if (KIND_EN(11) && IN(pb + 9)) { relaunder(F);
            pg8::ProbStatic P{(const char*)ob, (const char*)WoT, D, D, D, (size_t)256 * D * 2, 0, 0, (size_t)256 * D * 2, 0, 1, {}}; P.S.init(M / 256, D / 256, F.G, F.bid);
            pg8::EpiResF32 E{hbuf, ybuf, D, ALPHA}; pg8::gemm_phase<pg8::EpiResF32, pg8::ProbStatic, true>(F.lds, P, E, F.tid);
        }
        SEAM(pb + 9);
        if (KIND_EN(12) && IN(pb + 10)) { relaunder(F); ln_phase(F, ybuf, INP(13) + l * D, INP(14) + l * D, hbuf, hb); }
        SEAM(pb + 10);
        if (KIND_EN(13) && IN(pb + 11)) { relaunder(F); router_phase(F, hbuf, INP(15) + (size_t)l * D * NE, INP(16) + l * NE, F.ctl + CW_CNT + l * 64, tok_e, tok_slot, tok_gate, row_tok, row_gate); }
        SEAM(pb + 11);
        if (KIND_EN(14) && IN(pb + 12)) { relaunder(F); scatter_phase(F, F.ctl + CW_CNT + l * 64, tok_e, tok_slot, tok_gate, tok_pos, row_tok, row_gate, meta); }
        SEAM(pb + 12);
        if (KIND_EN(15) && IN(pb + 13)) { relaunder(F);
            LAS int* blkexp = (LAS int*)(F.lds + BLKEXP_OFF); LAS int* tokbuf = (LAS int*)(F.lds + TOKBUF_OFF); LAS float* gatebuf = (LAS float*)(F.lds + GATEBUF_OFF);
            const int nblk = meta[0];
            for (int i = F.tid; i < 640; i += NWAVES * 64) blkexp[i] = (i < nblk) ? meta[16 + i] : NE;
            __syncthreads();
            const int ntot = (nblk + 64) * 4;
            pg8::ProbMoe<true> P{(const char*)hb, (const char*)WguT, D, D, D, 4, (size_t)1024 * D * 2, (size_t)256 * D * 2, blkexp, tokbuf, nblk, ntot, (ntot + 7) / 8, F.bid & 7, F.bid >> 3, F.G >> 3};
            for (int i = 0; i < MAXORD; ++i) { pg8::Unit u; if (!P.next(i, u)) break;
                if (F.tid < 256) tokbuf[i * 256 + F.tid] = row_tok[u.pm * 256 + F.tid]; else gatebuf[i * 256 + F.tid - 256] = row_gate[u.pm * 256 + F.tid - 256]; }
            __syncthreads();
            pg8::EpiSwiGLU E{hid, gatebuf}; pg8::gemm_phase<pg8::EpiSwiGLU, pg8::ProbMoe<true>, true>(F.lds, P, E, F.tid);
        }
        SEAM(pb + 13);
        if (KIND_EN(16) && IN(pb + 14)) { relaunder(F);
            LAS int* blkexp = (LAS int*)(F.lds + BLKEXP_OFF);
            const int nblk = meta[0];
            for (int i = F.tid; i < 640; i += NWAVES * 64) blkexp[i] = (i < nblk) ? meta[16 + i] : NE;
            __syncthreads();
            const int ntot = (nblk + 64) * 8;
            pg8::ProbMoe<false> P{(const char*)hid, (const char*)WdT, DE, DE, DE, 8, (size_t)D * DE * 2, (size_t)256 * DE * 2, blkexp, nullptr, nblk, ntot, (ntot + 7) / 8, F.bid & 7, F.bid >> 3, F.G >> 3};
            pg8::EpiBf16 E{yrows, D, 1.0f}; pg8::gemm_phase<pg8::EpiBf16, pg8::ProbMoe<false>, true>(F.lds, P, E, F.tid);
        }
        SEAM(pb + 14);
        if (KIND_EN(17) && IN(pb + 15)) { relaunder(F); combine_phase(F, hbuf, yrows, tok_pos, INP(23) + l * D, INP(24) + l * D, (l == DEPTH - 1) ? OUTP : hbuf, (l == DEPTH - 1) ? nullptr : hb); }
        if (l + 1 < DEPTH) SEAM(pb + 15);
    }
    if (use_bar && hi == NPH) {
        if (__hip_atomic_load(F.ctl + CW_BAR + XB_TMO, RLX_AGENT) != 0u && F.tid == 0) { VM_WAIT(); OUTP[(size_t)F.bid * D] = __builtin_nanf(""); }
    }
#undef IN
#undef SEAM
}

extern "C" void kernel_launch(void* const* d_in, const int* in_sizes, int n_in, void* d_out, int out_size, void* d_ws, size_t ws_size, hipStream_t stream) {
    static int grid = 0;
    if (grid == 0) {
        if (n_in != 25 || in_sizes[0] != M * D || out_size != M * D || ws_size < WS_END) { fprintf(stderr, "kernel_launch: unexpected shapes (n_in %d, in0 %d, out %d, ws %zu, need %zu); nothing launched\n", n_in, n_in > 0 ? in_sizes[0] : -1, out_size, ws_size, (size_t)WS_END); grid = -1; return; }
        int dev = 0, cus = 0, per_cu = 0;
        if (hipGetDevice(&dev) != hipSuccess || hipDeviceGetAttribute(&cus, hipDeviceAttributeMultiprocessorCount, dev) != hipSuccess) { grid = -1; return; }
        if (hipFuncSetAttribute((const void*)mk_fwd, hipFuncAttributeMaxDynamicSharedMemorySize, LDS_BYTES) != hipSuccess) { fprintf(stderr, "kernel_launch: hipFuncSetAttribute failed\n"); grid = -1; return; }
        if (hipOccupancyMaxActiveBlocksPerMultiprocessor(&per_cu, (const void*)mk_fwd, NWAVES * 64, LDS_BYTES) != hipSuccess || per_cu < 1) fprintf(stderr, "kernel_launch: occupancy query reports %d\n", per_cu);
        (void)hipGetLastError();
        grid = cus;
        if (grid != 256) { fprintf(stderr, "kernel_launch: built for 256 CUs, device has %d; nothing launched\n", cus); grid = -1; return; }
    }
    if (grid < 0) return;
    if (hipMemsetAsync((char*)d_ws + WS_CTL, 0, CTL_ZERO_BYTES, stream) != hipSuccess) return;
    Args a{};
    for (int i = 0; i < 25; ++i) a.in[i] = (const float*)d_in[i];
    a.out = (float*)d_out; a.ws = (unsigned char*)d_ws;
#if MK_N_LAUNCHES == 1
    a.ph_lo = 0; a.ph_hi = NPH;
    hipLaunchKernelGGL(mk_fwd, dim3(grid), dim3(NWAVES * 64), LDS_BYTES, stream, a);
#else
    for (int p = 0; p < NPH; ++p) { a.ph_lo = p; a.ph_hi = p + 1; hipLaunchKernelGGL(mk_fwd, dim3(grid), dim3(NWAVES * 64), LDS_BYTES, stream, a); }
#endif
}
```

```cpp
#include <hip/hip_runtime.h>
#include <cstdio>
#include <cstdint>

#ifndef MK_N_LAUNCHES
#define MK_N_LAUNCHES 1
#endif
#ifndef MK_KINDS
#define MK_KINDS 0x3ffff
#endif
#define KIND_EN(k) (((MK_KINDS) >> (k)) & 1)

#define GAS __attribute__((address_space(1)))
#define LAS __attribute__((address_space(3)))
typedef unsigned short bf16;
typedef short bf16x8 __attribute__((ext_vector_type(8)));
typedef short s16x4 __attribute__((ext_vector_type(4)));
typedef float f32x4 __attribute__((ext_vector_type(4)));
typedef float f32x2 __attribute__((ext_vector_type(2)));
typedef unsigned u32x4 __attribute__((ext_vector_type(4)));
typedef unsigned u32x2 __attribute__((ext_vector_type(2)));
typedef LAS unsigned char lds_u8;
typedef GAS unsigned gu32;

constexpr int D = 2048, NBATCH = 4, SEQ = 4096, M = NBATCH * SEQ, DEPTH = 2;
constexpr int INW = 4352;
constexpr int NE = 64, TOPK = 8, DE = 512;
constexpr float ALPHA = 1.4142135623730951f;
constexpr float LN_EPS = 1e-5f, RMS_EPS = 1e-6f;
constexpr float LOG2E = 1.4426950408889634f;
constexpr int RB_SHARED0 = 576;
constexpr int NROWS = (RB_SHARED0 + 64) * 256;
constexpr int MAXORD = 12;

constexpr size_t MiB = 1u << 20;
constexpr size_t WS_CTL = 0, CTL_ZERO_BYTES = 1 * MiB;
constexpr size_t WS_META = 1 * MiB;
constexpr size_t WS_TOKE = 2 * MiB, WS_TOKSLOT = 2 * MiB + 512 * 1024, WS_TOKGATE = 3 * MiB, WS_TOKPOS = 3 * MiB + 512 * 1024;
constexpr size_t WS_ROWTOK = 4 * MiB, WS_ROWGATE = 5 * MiB;
constexpr size_t WS_MEMB = 6 * MiB, WS_KC = 10 * MiB, WS_VT = 18 * MiB;
constexpr size_t WS_WIN = 26 * MiB, WS_WOUT = 43 * MiB, WS_WQ = 51 * MiB, WS_WO = 59 * MiB, WS_WGU = 67 * MiB, WS_WD = 327 * MiB;
constexpr size_t WS_H = 457 * MiB, WS_HB = 585 * MiB, WS_Y = 649 * MiB, WS_R = 777 * MiB;
constexpr size_t WS_PROJ = WS_R, WS_OA = WS_R + 136 * MiB, WS_OB = WS_R + 168 * MiB, WS_LSE = WS_R + 264 * MiB, WS_MIXED = WS_R + 267 * MiB;
constexpr size_t WS_Q = WS_R + 331 * MiB, WS_P = WS_R + 395 * MiB, WS_O = WS_R + 427 * MiB;
constexpr size_t WS_WKT = WS_R, WS_WVT = WS_R + 16 * MiB;
constexpr size_t WS_HID = WS_R, WS_YROWS = WS_R + 160 * MiB;
constexpr size_t WS_END = WS_R + 800 * MiB;
constexpr int CW_TMO = 0, CW_CODE = 1;
constexpr int CW_BAR = 4096;
constexpr int CW_CNT = 16384;

constexpr int RING_BYTES = 131072;
constexpr int AUX_OFF = RING_BYTES;
constexpr int TOKBUF_OFF = AUX_OFF, GATEBUF_OFF = AUX_OFF + MAXORD * 1024, BLKEXP_OFF = GATEBUF_OFF + MAXORD * 1024;
constexpr int MISC_OFF = BLKEXP_OFF + 2560;
constexpr int LDS_BYTES = MISC_OFF + 256;
static_assert(LDS_BYTES <= 160 * 1024 && (MISC_OFF % 16) == 0, "LDS map");

#define RLX_AGENT __ATOMIC_RELAXED, __HIP_MEMORY_SCOPE_AGENT
#define LDS_WAIT() asm volatile("s_waitcnt lgkmcnt(0)" ::: "memory")
#define VM_WAIT() asm volatile("s_waitcnt vmcnt(0)" ::: "memory")
__device__ __forceinline__ unsigned cvt_pk_bf16(float lo, float hi) { unsigned r; asm volatile("v_cvt_pk_bf16_f32 %0, %1, %2" : "=v"(r) : "v"(lo), "v"(hi)); return r; }
__device__ __forceinline__ float bf_lo(unsigned w) { return __uint_as_float(w << 16); }
__device__ __forceinline__ float bf_hi(unsigned w) { return __uint_as_float(w & 0xffff0000u); }
__device__ __forceinline__ float wave_sum(float v) {
#pragma unroll
    for (int o = 1; o < 64; o <<= 1) v += __shfl_xor(v, o);
    return v;
}

#define XB_TMO      128
#define XB_XCNT(j)  (256  + 64 * (j))
#define XB_XSUB(j)  (1280 + 64 * (j))
#define XB_XGEN(j)  (2304 + 64 * (j))
#define XB_TOP      3328
#define XB_TOPGEN   3392
#define XCD_BAR_WORDS 3456
#define XB_SPIN_CAP (1u << 18)
__device__ __forceinline__ unsigned xb_ld(unsigned* p)              { return __hip_atomic_load(p, __ATOMIC_RELAXED, __HIP_MEMORY_SCOPE_AGENT); }
__device__ __forceinline__ unsigned xb_add(unsigned* p, unsigned v) { return __hip_atomic_fetch_add(p, v, __ATOMIC_RELAXED, __HIP_MEMORY_SCOPE_AGENT); }
__device__ __forceinline__ unsigned xb_xcc_id() { return (unsigned)__builtin_amdgcn_s_getreg((3 << 11) | 20) & 0xFu; }
#define XB_SPIN(cond, bar) do { unsigned _sp = 0; while (cond) { __builtin_amdgcn_s_sleep(1); \
    if ((++_sp & 255u) == 0u) { if (xb_ld(&(bar)[XB_TMO])) break; if (_sp > XB_SPIN_CAP) { atomicAdd(&(bar)[XB_TMO], 1u); break; } } } } while (0)
struct XcdBarrier { unsigned* bar; unsigned x; volatile LAS unsigned* st; };
__device__ __forceinline__ XcdBarrier xcd_barrier_post(unsigned* bar, volatile LAS unsigned* st) {
    XcdBarrier b; b.bar = bar; b.x = xb_xcc_id(); b.st = st;
    if (threadIdx.x == 0) (void)xb_add(&bar[XB_XCNT(b.x)], 1u);
    return b;
}
__device__ __forceinline__ void xcd_barrier_complete(unsigned* bar, unsigned x, unsigned& nloc, unsigned& nx) {
    const unsigned G = gridDim.x * gridDim.y * gridDim.z;
    unsigned sum, cnt, mine, sp = 0u;
    for (;;) {
        sum = 0u; cnt = 0u; mine = 0u;
#pragma unroll
        for (unsigned j = 0; j < 16; ++j) { const unsigned c = xb_ld(&bar[XB_XCNT(j)]); sum += c; cnt += (c > 0u) ? 1u : 0u; mine = (j == x) ? c : mine; }
        if (sum == G) break;
        __builtin_amdgcn_s_sleep(1);
        if ((++sp & 255u) == 0u) { if (xb_ld(&bar[XB_TMO])) break; if (sp > XB_SPIN_CAP) { atomicAdd(&bar[XB_TMO], 1u); break; } }
    }
    nloc = mine > 0u ? mine : 1u; nx = cnt > 0u ? cnt : 1u;
}
__device__ __forceinline__ void xcd_barrier(const XcdBarrier& b) {
    asm volatile("s_waitcnt vmcnt(0)" ::: "memory");
    __syncthreads();
    if (threadIdx.x == 0) {
        unsigned* bar = b.bar;
        __builtin_amdgcn_s_waitcnt(0);
        unsigned nloc = b.st[0], nx = b.st[1];
        if (nloc == 0u) { xcd_barrier_complete(bar, b.x, nloc, nx); b.st[0] = nloc; b.st[1] = nx; }
        const unsigned old = xb_add(&bar[XB_XSUB(b.x)], 1u);
        const unsigned gen = old / nloc;
        if (old + 1u == (gen + 1u) * nloc) {
            __builtin_amdgcn_fence(__ATOMIC_RELEASE, "agent");
            asm volatile("s_waitcnt vmcnt(0)" ::: "memory");
            const unsigned og = xb_add(&bar[XB_TOP], 1u);
            const unsigned tg = og / nx;
            if (og + 1u == (tg + 1u) * nx) xb_add(&bar[XB_TOPGEN], 1u);
            else XB_SPIN(xb_ld(&bar[XB_TOPGEN]) == tg, bar);
            __builtin_amdgcn_fence(__ATOMIC_ACQUIRE, "agent");
            xb_add(&bar[XB_XGEN(b.x)], 1u);
            asm volatile("s_waitcnt vmcnt(0)" ::: "memory");
        } else {
            XB_SPIN(xb_ld(&bar[XB_XGEN(b.x)]) == gen, bar);
            __builtin_amdgcn_fence(__ATOMIC_ACQUIRE, "agent");
            asm volatile("s_waitcnt vmcnt(0)" ::: "memory");
        }
    }
    __syncthreads();
}

namespace pg8 {
constexpr int BM = 256, BK = 64, HALF = 128, HTB = HALF * BK * 2, STAGE_BYTES = 8 * HTB, NXCD = 8, WGM = 8;
__host__ __device__ __forceinline__ int lds_byte(int r, int c) { const int st = (r >> 4) * 2 + (c >> 5), rr = r & 15, cc = c & 31, ob = rr * 64 + cc * 2; return st * 1024 + (ob ^ (((ob >> 9) & 1) << 5)); }
__host__ __device__ __forceinline__ void stage_rc(int b, int& R, int& C) { const int st = b / 1024, sb = b % 1024, swz = sb ^ (((sb >> 9) & 1) << 5); R = (st >> 1) * 16 + swz / 64; C = (st & 1) * 32 + (swz % 64) / 2; }
__host__ __device__ __forceinline__ int perm32(int rho) { const int n = rho >> 4, i = rho & 15; return 8 * (i >> 2) + 4 * n + (i & 3); }

struct Unit { int pm, pn, ex, ord; };

struct StaticOrder {
    int nM, nN, nwg, G, c;
    __device__ void init(int nM_, int nN_, int G_, int c_) { nM = nM_; nN = nN_; nwg = nM * nN; G = G_; c = c_; }
    __device__ bool next(int i, Unit& u) const {
        const long L = (long)i * G + c; if (L >= nwg) return false;
        int wgid = (int)L; { const int q = nwg / NXCD, r = nwg % NXCD, xcd = wgid % NXCD, off = wgid / NXCD; wgid = (xcd < r ? xcd * (q + 1) : r * (q + 1) + (xcd - r) * q) + off; }
        const int nig = WGM * nN, gid = wgid / nig, fm = gid * WGM, gsz = (nM - fm) < WGM ? (nM - fm) : WGM;
        u.pm = fm + ((wgid % nig) % gsz); u.pn = (wgid % nig) / gsz; u.ex = 0; u.ord = i; return true;
    }
};

struct ProbStatic {
    const char* A0; const char* B0; int lda, ldb, K;
    size_t a_pm_step, a_pn_step; int a_pn_shift; size_t b_pn_step, b_batch_step; int batch_div;
    StaticOrder S;
    __device__ __forceinline__ bool next(int i, Unit& u) const { return S.next(i, u); }
    __device__ __forceinline__ const char* a_base(const Unit& u) const { return A0 + (size_t)u.pm * a_pm_step + (size_t)(u.pn >> a_pn_shift) * a_pn_step; }
    __device__ __forceinline__ const char* b_base(const Unit& u) const { return B0 + (size_t)u.pn * b_pn_step + (size_t)(u.pm / batch_div) * b_batch_step; }
    __device__ __forceinline__ void a_offs(const Unit&, const int (&R)[2], const int (&C)[2], unsigned (&vo)[2][2]) const {
#pragma unroll
        for (int h = 0; h < 2; ++h)
#pragma unroll
            for (int i = 0; i < 2; ++i) vo[h][i] = (unsigned)((R[i] + HALF * h) * lda + C[i]) * 2u;
    }
};

template <bool GATHER> struct ProbMoe {
    const char* A0; const char* B0; int lda, ldb, K, npn; size_t b_e_step, b_pn_step;
    const LAS int* blkexp; const LAS int* tokbuf; int nblk, ntot, chunk, xcd, rank, nrank;
    __device__ __forceinline__ bool next(int i, Unit& u) const {
        const int idx = xcd * chunk + i * nrank + rank; int lim = (xcd + 1) * chunk; lim = lim < ntot ? lim : ntot;
        if (idx >= lim || i * nrank + rank >= chunk) return false;
        const int lb = idx / npn; u.pn = idx - lb * npn;
        if (lb < nblk) { u.pm = lb; u.ex = blkexp[lb]; } else { u.pm = RB_SHARED0 + (lb - nblk); u.ex = NE; }
        u.ord = i; return true;
    }
    __device__ __forceinline__ const char* a_base(const Unit& u) const { return GATHER ? A0 : A0 + (size_t)u.pm * BM * lda * 2; }
    __device__ __forceinline__ const char* b_base(const Unit& u) const { return B0 + (size_t)u.ex * b_e_step + (size_t)u.pn * b_pn_step; }
    __device__ __forceinline__ void a_offs(const Unit& u, const int (&R)[2], const int (&C)[2], unsigned (&vo)[2][2]) const {
#pragma unroll
        for (int h = 0; h < 2; ++h)
#pragma unroll
            for (int i = 0; i < 2; ++i) {
                if (GATHER) { const int tok = tokbuf[u.ord * 256 + R[i] + HALF * h]; vo[h][i] = (unsigned)(tok * lda + C[i]) * 2u; }
                else vo[h][i] = (unsigned)((R[i] + HALF * h) * lda + C[i]) * 2u;
            }
    }
};

struct EpiBf16 {
    static constexpr bool PERM = true, AFTER_DRAIN = false;
    bf16* O; int ldc; float scale;
    __device__ __forceinline__ void operator()(const f32x4 (&acc)[2][2][4][2], const Unit& u, int wr, int wc, int fr, int fq) const {
        const int row0 = u.pm * BM + wr * 64 + fr, col0 = u.pn * BM + wc * 32 + 8 * fq;
#pragma unroll
        for (int ai = 0; ai < 2; ++ai)
#pragma unroll
            for (int m = 0; m < 4; ++m) { bf16* rowp = O + (size_t)(row0 + ai * HALF + m * 16) * ldc + col0;
#pragma unroll
                for (int bj = 0; bj < 2; ++bj) { const f32x4 v0 = acc[ai][bj][m][0] * scale, v1 = acc[ai][bj][m][1] * scale;
                    u32x4 w; w.x = cvt_pk_bf16(v0[0], v0[1]); w.y = cvt_pk_bf16(v0[2], v0[3]); w.z = cvt_pk_bf16(v1[0], v1[1]); w.w = cvt_pk_bf16(v1[2], v1[3]);
                    *(u32x4*)(rowp + bj * HALF) = w; } }
    }
};
struct EpiResF32 {
    static constexpr bool PERM = false, AFTER_DRAIN = false;
    const float* base; float* Y; int ldc; float alpha;
    __device__ __forceinline__ void operator()(const f32x4 (&acc)[2][2][4][2], const Unit& u, int wr, int wc, int fr, int fq) const {
        const int row0 = u.pm * BM + wr * 64 + fr, col0 = u.pn * BM + wc * 32 + 4 * fq;
#pragma unroll
        for (int ai = 0; ai < 2; ++ai)
#pragma unroll
            for (int m = 0; m < 4; ++m) { const size_t off = (size_t)(row0 + ai * HALF + m * 16) * ldc + col0;
#pragma unroll
                for (int bj = 0; bj < 2; ++bj)
#pragma unroll
                    for (int n = 0; n < 2; ++n) { const f32x4 b = *(const f32x4*)(base + off + bj * HALF + n * 16); *(f32x4*)(Y + off + bj * HALF + n * 16) = b * alpha + acc[ai][bj][m][n]; } }
    }
};
struct EpiSwiGLU {
    static constexpr bool PERM = true, AFTER_DRAIN = false;
    bf16* Hd; const LAS float* gatebuf;
    __device__ __forceinline__ void operator()(const f32x4 (&acc)[2][2][4][2], const Unit& u, int wr, int wc, int fr, int fq) const {
        const int r0 = wr * 64 + fr, col0 = u.pn * HALF + wc * 32 + 8 * fq;
#pragma unroll
        for (int ai = 0; ai < 2; ++ai)
#pragma unroll
            for (int m = 0; m < 4; ++m) { const int r = r0 + ai * HALF + m * 16; const float gt = gatebuf[u.ord * 256 + r];
                float o[8];
#pragma unroll
                for (int n = 0; n < 2; ++n)
#pragma unroll
                    for (int e = 0; e < 4; ++e) { const float g = acc[ai][0][m][n][e], up = acc[ai][1][m][n][e];
                        const float sg = g * __builtin_amdgcn_rcpf(1.0f + __builtin_amdgcn_exp2f(-g * LOG2E)); o[n * 4 + e] = sg * up * gt; }
                u32x4 w; w.x = cvt_pk_bf16(o[0], o[1]); w.y = cvt_pk_bf16(o[2], o[3]); w.z = cvt_pk_bf16(o[4], o[5]); w.w = cvt_pk_bf16(o[6], o[7]);
                *(u32x4*)(Hd + (size_t)(u.pm * BM + r) * DE + col0) = w; }
    }
};
struct EpiSoftmax {
    static constexpr bool PERM = true, AFTER_DRAIN = true;
    bf16* O; int ldc; float scale2;
    __device__ __forceinline__ void operator()(const f32x4 (&)[2][2][4][2], const Unit&, int, int, int, int) const {}
    __device__ __forceinline__ void fused(f32x4 (&acc)[2][2][4][2], const Unit& u, int wr, int wc, int fr, int fq, lds_u8* lds, int wid, int lane) const {
        LAS float* X = (LAS float*)lds;
        LAS float* Z = (LAS float*)(lds + 4096);
        float mx[2][4];
#pragma unroll
        for (int ai = 0; ai < 2; ++ai)
#pragma unroll
            for (int m = 0; m < 4; ++m) { float v = -3.0e38f;
#pragma unroll
                for (int bj = 0; bj < 2; ++bj)
#pragma unroll
                    for (int n = 0; n < 2; ++n) { acc[ai][bj][m][n] = acc[ai][bj][m][n] * scale2; const f32x4 x = acc[ai][bj][m][n]; v = fmaxf(v, fmaxf(fmaxf(x[0], x[1]), fmaxf(x[2], x[3]))); }
                v = fmaxf(v, __shfl_xor(v, 16)); v = fmaxf(v, __shfl_xor(v, 32));
                if (fq == 0) X[(ai * HALF + wr * 64 + m * 16 + fr) * 4 + wc] = v; }
        asm volatile("s_waitcnt lgkmcnt(0)" ::: "memory"); __builtin_amdgcn_s_barrier(); asm volatile("" ::: "memory");
#pragma unroll
        for (int ai = 0; ai < 2; ++ai)
#pragma unroll
            for (int m = 0; m < 4; ++m) { const int r = ai * HALF + wr * 64 + m * 16 + fr; const f32x4 t = *(const LAS f32x4*)(X + r * 4);
                const float mm = fmaxf(fmaxf(t[0], t[1]), fmaxf(t[2], t[3])); mx[ai][m] = mm; float s = 0.f;
#pragma unroll
                for (int bj = 0; bj < 2; ++bj)
#pragma unroll
                    for (int n = 0; n < 2; ++n) { f32x4 x = acc[ai][bj][m][n];
#pragma unroll
                        for (int e = 0; e < 4; ++e) x[e] = __builtin_amdgcn_exp2f(x[e] - mm);
                        acc[ai][bj][m][n] = x; s += (x[0] + x[1]) + (x[2] + x[3]); }
                s += __shfl_xor(s, 16); s += __shfl_xor(s, 32);
                if (fq == 0) Z[r * 4 + wc] = s; }
        asm volatile("s_waitcnt lgkmcnt(0)" ::: "memory"); __builtin_amdgcn_s_barrier(); asm volatile("" ::: "memory");
        const int row0 = u.pm * BM + wr * 64 + fr, col0 = u.pn * BM + wc * 32 + 8 * fq;
#pragma unroll
        for (int ai = 0; ai < 2; ++ai)
#pragma unroll
            for (int m = 0; m < 4; ++m) { const int r = ai * HALF + wr * 64 + m * 16 + fr; const f32x4 t = *(const LAS f32x4*)(Z + r * 4);
                const float inv = 1.0f / ((t[0] + t[1]) + (t[2] + t[3]));
                bf16* rowp = O + (size_t)(row0 + ai * HALF + m * 16) * ldc + col0;
#pragma unroll
                for (int bj = 0; bj < 2; ++bj) { const f32x4 v0 = acc[ai][bj][m][0] * inv, v1 = acc[ai][bj][m][1] * inv;
                    u32x4 w; w.x = cvt_pk_bf16(v0[0], v0[1]); w.y = cvt_pk_bf16(v0[2], v0[3]); w.z = cvt_pk_bf16(v1[0], v1[1]); w.w = cvt_pk_bf16(v1[2], v1[3]);
                    *(u32x4*)(rowp + bj * HALF) = w; } }
        (void)mx; (void)wid; (void)lane;
    }
};

template <class Epi, class Prob, bool ALIGN_EPI>
__device__ __forceinline__ void gemm_phase(lds_u8* lds, const Prob& P, const Epi& E, const int tid) {
    const int wid = __builtin_amdgcn_readfirstlane(tid >> 6), lane = tid & 63, wr = wid >> 2, wc = wid & 3, fr = lane & 15, fq = lane >> 4;
    const int nt = P.K / BK;
    int Rr[2], Cc[2]; unsigned voffB[2];
#pragma unroll
    for (int i = 0; i < 2; ++i) { stage_rc(tid * 16 + i * 8192, Rr[i], Cc[i]); const int Rb = Epi::PERM ? ((Rr[i] & ~31) + perm32(Rr[i] & 31)) : Rr[i];
        voffB[i] = (unsigned)(Rb * P.ldb + Cc[i]) * 2u; }
    const size_t kstep = (size_t)(BK * 2);
    const size_t hstepB = (size_t)HALF * P.ldb * 2;
    const unsigned ldsw = (unsigned)wid * 1024u;
    const int aoff = lds_byte(wr * 64 + fr, fq * 8), boff = lds_byte(wc * 32 + fr, fq * 8);
#define PG8_SA(b, h) (((b) * 2 + (h)) * HTB)
#define PG8_SB(b, h) ((4 + (b) * 2 + (h)) * HTB)
#define PG8_STAGE(bufoff, gbase, voff) do { _Pragma("unroll") for (int _i = 0; _i < 2; ++_i) \
        __builtin_amdgcn_global_load_lds((const unsigned*)((const char*)(gbase) + (voff)[_i]), (LAS unsigned*)(lds + (bufoff) + ldsw + _i * 8192), 16, 0, 0); } while (0)
#define PG8_LDA(dst, b, h) do { _Pragma("unroll") for (int m = 0; m < 4; ++m) _Pragma("unroll") for (int k = 0; k < 2; ++k) dst[m][k] = *(const LAS bf16x8*)(lds + PG8_SA(b, h) + aoff + m * 2048 + k * 1024); } while (0)
#define PG8_LDB(dst, b, h) do { _Pragma("unroll") for (int n = 0; n < 2; ++n) _Pragma("unroll") for (int k = 0; k < 2; ++k) dst[n][k] = *(const LAS bf16x8*)(lds + PG8_SB(b, h) + boff + n * 2048 + k * 1024); } while (0)
#define PG8_MMA(ai, bj, At, Bt) do { __builtin_amdgcn_s_setprio(1); _Pragma("unroll") for (int m = 0; m < 4; ++m) _Pragma("unroll") for (int n = 0; n < 2; ++n) _Pragma("unroll") for (int k = 0; k < 2; ++k) \
        acc[ai][bj][m][n] = __builtin_amdgcn_mfma_f32_16x16x32_bf16(Bt[n][k], At[m][k], acc[ai][bj][m][n], 0, 0, 0); __builtin_amdgcn_s_setprio(0); } while (0)
#define PG8_WAIT_V(n) asm volatile("s_waitcnt vmcnt(" #n ")" ::: "memory")
#define PG8_WAIT_L(n) asm volatile("s_waitcnt lgkmcnt(" #n ")" ::: "memory")
#define PG8_BAR __builtin_amdgcn_s_barrier()
#define PG8_SCHED __builtin_amdgcn_sched_barrier(0)
    Unit cur, nxt; int ui = 0;
    if (!P.next(0, cur)) return;
    f32x4 acc[2][2][4][2];
#pragma unroll
    for (int a = 0; a < 2; ++a)
#pragma unroll
        for (int b = 0; b < 2; ++b)
#pragma unroll
            for (int m = 0; m < 4; ++m)
#pragma unroll
                for (int n = 0; n < 2; ++n) acc[a][b][m][n] = (f32x4){0.f, 0.f, 0.f, 0.f};
    bf16x8 At[4][2], B0[2][2], B1[2][2];
    unsigned vA[2][2], nvA[2][2];
    P.a_offs(cur, Rr, Cc, vA);
    const char* cA = P.a_base(cur); const char* cB = P.b_base(cur);
    PG8_STAGE(PG8_SB(0, 0), cB, voffB); PG8_STAGE(PG8_SB(0, 1), cB + hstepB, voffB); PG8_STAGE(PG8_SA(0, 0), cA, vA[0]); PG8_STAGE(PG8_SA(0, 1), cA, vA[1]);
    if (wr == 1) PG8_BAR;
    PG8_WAIT_V(2); PG8_BAR;
    PG8_STAGE(PG8_SB(1, 0), cB + kstep, voffB); PG8_STAGE(PG8_SA(1, 0), cA + kstep, vA[0]); PG8_STAGE(PG8_SB(1, 1), cB + hstepB + kstep, voffB);
    PG8_WAIT_V(6); PG8_BAR;
    for (;;) {
        const bool has_next = P.next(ui + 1, nxt);
        const char* nA = cA; const char* nB = cB;
#pragma unroll
        for (int h = 0; h < 2; ++h)
#pragma unroll
            for (int i = 0; i < 2; ++i) nvA[h][i] = vA[h][i];
        if (has_next) { nA = P.a_base(nxt); nB = P.b_base(nxt); P.a_offs(nxt, Rr, Cc, nvA); }
        for (int t = 0; t < nt; t += 2) {
            const bool last = (t == nt - 2);
            const char* a1 = cA + (size_t)(t + 1) * kstep;
            const char* a2 = last ? nA : cA + (size_t)(t + 2) * kstep; const char* b2 = last ? nB : cB + (size_t)(t + 2) * kstep;
            const char* a3 = a2 + kstep; const char* b3 = b2 + kstep;
            unsigned o2a[2], o2b[2];
#pragma unroll
            for (int i = 0; i < 2; ++i) { o2a[i] = last ? nvA[0][i] : vA[0][i]; o2b[i] = last ? nvA[1][i] : vA[1][i]; }
            PG8_LDB(B0, 0, 0); PG8_LDB(B1, 0, 1); PG8_SCHED; PG8_LDA(At, 0, 0); PG8_STAGE(PG8_SA(1, 1), a1, vA[1]);
            PG8_WAIT_V(8); PG8_WAIT_L(0); PG8_BAR; PG8_MMA(0, 0, At, B0); PG8_MMA(0, 1, At, B1); PG8_BAR; PG8_SCHED;
            PG8_LDA(At, 0, 1); PG8_STAGE(PG8_SB(0, 0), b2, voffB); PG8_STAGE(PG8_SB(0, 1), b2 + hstepB, voffB); PG8_STAGE(PG8_SA(0, 0), a2, o2a);
            PG8_WAIT_V(8); PG8_WAIT_L(0); PG8_BAR; PG8_MMA(1, 0, At, B0); PG8_MMA(1, 1, At, B1); PG8_BAR; PG8_SCHED;
            PG8_LDB(B0, 1, 0); PG8_LDB(B1, 1, 1); PG8_SCHED; PG8_LDA(At, 1, 0); PG8_STAGE(PG8_SA(0, 1), a2, o2b);
            PG8_WAIT_V(8); PG8_WAIT_L(0); PG8_BAR; PG8_MMA(0, 0, At, B0); PG8_MMA(0, 1, At, B1); PG8_BAR; PG8_SCHED;
            PG8_LDA(At, 1, 1); PG8_STAGE(PG8_SB(1, 0), b3, voffB); PG8_STAGE(PG8_SB(1, 1), b3 + hstepB, voffB); PG8_STAGE(PG8_SA(1, 0), a3, o2a);
            PG8_WAIT_V(8); PG8_WAIT_L(0); PG8_BAR; PG8_MMA(1, 0, At, B0); PG8_MMA(1, 1, At, B1); PG8_BAR; PG8_SCHED;
        }
        if constexpr (ALIGN_EPI) { if (wr == 0) PG8_BAR; }
        if constexpr (!Epi::AFTER_DRAIN) { E(acc, cur, wr, wc, fr, fq); }
        if (!has_next) break;
#pragma unroll
        for (int a = 0; a < 2; ++a)
#pragma unroll
            for (int b = 0; b < 2; ++b)
#pragma unroll
                for (int m = 0; m < 4; ++m)
#pragma unroll
                    for (int n = 0; n < 2; ++n) acc[a][b][m][n] = (f32x4){0.f, 0.f, 0.f, 0.f};
        cur = nxt; cA = nA; cB = nB; ++ui;
#pragma unroll
        for (int h = 0; h < 2; ++h)
#pragma unroll
            for (int i = 0; i < 2; ++i) vA[h][i] = nvA[h][i];
        if constexpr (ALIGN_EPI) { if (wr == 1) PG8_BAR; }
    }
    PG8_WAIT_V(0);
    if constexpr (!ALIGN_EPI) { if (wr == 0) PG8_BAR; }
    PG8_BAR;
    if constexpr (Epi::AFTER_DRAIN) { E.fused(acc, cur, wr, wc, fr, fq, lds, wid, lane); }
#undef PG8_SA
#undef PG8_SB
#undef PG8_STAGE
#undef PG8_LDA
#undef PG8_LDB
#undef PG8_MMA
#undef PG8_WAIT_V
#undef PG8_WAIT_L
#undef PG8_BAR
#undef PG8_SCHED
}
}

constexpr int NWAVES = 8;
struct Args {
    const float* in[25]; float* out; unsigned char* ws; int ph_lo, ph_hi;
};
static_assert(sizeof(Args) == 224, "Args layout (kernarg offsets in ka_ptr users)");
struct Frame {
    lds_u8* lds; volatile LAS unsigned* MISC; gu32* ctl;
    int tid, lane, wave, G, bid;
};
__device__ __forceinline__ void relaunder(Frame& F) { int t = threadIdx.x; asm volatile("" : "+v"(t)); F.tid = t; F.lane = t & 63; F.wave = __builtin_amdgcn_readfirstlane(t >> 6); int b = blockIdx.x; asm volatile("" : "+s"(b)); F.bid = b; }


typedef const unsigned char* cptr_t;
__device__ __forceinline__ cptr_t ka_ptr(int off) { const __attribute__((address_space(4))) unsigned char* p = (const __attribute__((address_space(4))) unsigned char*)__builtin_amdgcn_kernarg_segment_ptr(); asm volatile("" : "+s"(p)); return *(const __attribute__((address_space(4))) cptr_t*)(p + off); }
#define INP(i) ((const float*)ka_ptr(8 * (i)))
#define OUTP ((float*)ka_ptr(200))
#define WSP ((unsigned char*)ka_ptr(208))

struct Row { f32x4 v[8]; };
__device__ __forceinline__ void row_load_f32(Row& r, const float* p, int lane) {
#pragma unroll
    for (int j = 0; j < 4; ++j) { const f32x4* q = (const f32x4*)(p + 512 * j + 8 * lane); r.v[2 * j] = q[0]; r.v[2 * j + 1] = q[1]; }
}
__device__ __forceinline__ void row_store_f32(const Row& r, float* p, int lane) {
#pragma unroll
    for (int j = 0; j < 4; ++j) { f32x4* q = (f32x4*)(p + 512 * j + 8 * lane); q[0] = r.v[2 * j]; q[1] = r.v[2 * j + 1]; }
}
__device__ __forceinline__ void row_store_bf16(const Row& r, bf16* p, int lane) {
#pragma unroll
    for (int j = 0; j < 4; ++j) { const f32x4 a = r.v[2 * j], b = r.v[2 * j + 1]; u32x4 w; w.x = cvt_pk_bf16(a[0], a[1]); w.y = cvt_pk_bf16(a[2], a[3]); w.z = cvt_pk_bf16(b[0], b[1]); w.w = cvt_pk_bf16(b[2], b[3]);
        *(u32x4*)(p + 512 * j + 8 * lane) = w; }
}
__device__ __forceinline__ void row_add_bf16(Row& r, const bf16* p, int lane) {
#pragma unroll
    for (int j = 0; j < 4; ++j) { const u32x4 w = *(const u32x4*)(p + 512 * j + 8 * lane);
        r.v[2 * j] += (f32x4){bf_lo(w.x), bf_hi(w.x), bf_lo(w.y), bf_hi(w.y)}; r.v[2 * j + 1] += (f32x4){bf_lo(w.z), bf_hi(w.z), bf_lo(w.w), bf_hi(w.w)}; }
}
__device__ __forceinline__ void row_layernorm(Row& r, const Row& g, const Row& b) {
    float s = 0.f;
#pragma unroll
    for (int i = 0; i < 8; ++i) s += (r.v[i][0] + r.v[i][1]) + (r.v[i][2] + r.v[i][3]);
    const float mean = wave_sum(s) * (1.0f / D); float s2 = 0.f;
#pragma unroll
    for (int i = 0; i < 8; ++i) { r.v[i] = r.v[i] - mean; s2 += (r.v[i][0] * r.v[i][0] + r.v[i][1] * r.v[i][1]) + (r.v[i][2] * r.v[i][2] + r.v[i][3] * r.v[i][3]); }
    const float rstd = 1.0f / sqrtf(wave_sum(s2) * (1.0f / D) + LN_EPS);
#pragma unroll
    for (int i = 0; i < 8; ++i) r.v[i] = r.v[i] * rstd * g.v[i] + b.v[i];
}

__device__ __forceinline__ void tr_item(const float* W, int N, int k0, int n0, bf16* WT, size_t orow0, int K, LAS float* scr, int lane) {
    f32x4 v[16];
#pragma unroll
    for (int i = 0; i < 16; ++i) v[i] = *(const f32x4*)(W + (size_t)(k0 + 4 * i + (lane >> 4)) * N + n0 + 4 * (lane & 15));
#pragma unroll
    for (int i = 0; i < 16; ++i) { LAS float* s = scr + (4 * i + (lane >> 4)) * 65 + 4 * (lane & 15); s[0] = v[i][0]; s[1] = v[i][1]; s[2] = v[i][2]; s[3] = v[i][3]; }
    LDS_WAIT(); asm volatile("" ::: "memory");
    const int c = lane >> 3;
#pragma unroll
    for (int p = 0; p < 8; ++p) { const int n = 8 * p + (lane & 7); const LAS float* s = scr + (8 * c) * 65 + n;
        u32x4 o; o.x = cvt_pk_bf16(s[0 * 65], s[1 * 65]); o.y = cvt_pk_bf16(s[2 * 65], s[3 * 65]); o.z = cvt_pk_bf16(s[4 * 65], s[5 * 65]); o.w = cvt_pk_bf16(s[6 * 65], s[7 * 65]);
        *(u32x4*)(WT + (orow0 + n) * (size_t)K + k0 + 8 * c) = o; }
    LDS_WAIT(); asm volatile("" ::: "memory");
}
template <bool GU> __device__ __forceinline__ void tr_matrix_item(const float* W, int K, int N, bf16* WT, size_t orow_base, int item, LAS float* scr, int lane) {
    const int nblk = N / 64, kb = item / nblk, nb = item % nblk, n0 = nb * 64;
    const size_t orow0 = orow_base + (GU ? (size_t)((n0 >> 7) * 256 + (n0 & 127)) : (size_t)n0);
    tr_item(W, N, kb * 64, n0, WT, orow0, K, scr, lane);
}

constexpr int ATT_ROWB = 160;
constexpr int ATT_TILE = 272 * ATT_ROWB;
typedef short v4i16_t __attribute__((ext_vector_type(4)));
__device__ __forceinline__ s16x4 vtr(const lds_u8* p) { return __builtin_bit_cast(s16x4, __builtin_amdgcn_ds_read_tr16_b64_v4i16((LAS v4i16_t*)p)); }
__device__ __forceinline__ void attn_phase(Frame& F, const bf16* proj, const float* sinks, bf16* oA, bf16* oB, float* lseB) {
    lds_u8* Kt = F.lds; lds_u8* Vt = F.lds + ATT_TILE;
    const int tid = F.tid, wid = F.wave, lane = F.lane, fr = lane & 15, fq = lane >> 4;
    for (int i = tid; i < 2 * 640; i += NWAVES * 64) { lds_u8* base = (i >= 640) ? Vt : Kt; *(LAS unsigned*)(base + 256 * ATT_ROWB + (i % 640) * 4) = 0u; }
    __syncthreads();
    for (int u = F.bid; u < 8192; u += F.G) {
        const int kind = u >> 11, rem = u & 2047, b = rem >> 9, h = (rem >> 5) & 15, j32 = rem & 31;
        const int dsh = (kind <= 1) ? 0 : (kind == 2 ? 2 : 4), d = 1 << dsh, nbpr = 32 >> dsh, r = j32 / nbpr, nb = j32 % nbpr;
        const int qcol = (kind == 0) ? h * 64 : 1280 + h * 64, kcol = (kind == 0) ? 1024 + (h >> 3) * 64 : 2304 + h * 64, vcol = (kind == 0) ? 1152 + (h >> 3) * 64 : 3328 + h * 64;
        const int max_off = (kind == 0) ? 127 : 128;
        const float slope2 = __builtin_amdgcn_exp2f(-0.5f * (float)(h + 1)) * (float)d * LOG2E;
        const float sink2 = (kind == 0) ? sinks[h] * LOG2E : -__builtin_inff();
        const size_t tok0 = (size_t)b * SEQ + r;
#pragma unroll
        for (int i = 0; i < 4; ++i) { const int row = (tid >> 3) + 64 * i, c = tid & 7; int t = (nb - 1) * 128 + row; t = t < 0 ? 0 : t;
            const bf16* src = proj + (tok0 + (size_t)d * t) * INW + c * 8;
            const u32x4 kv = *(const u32x4*)(src + kcol), vv = *(const u32x4*)(src + vcol);
            *(LAS u32x4*)(Kt + row * ATT_ROWB + c * 16) = kv; *(LAS u32x4*)(Vt + row * ATT_ROWB + c * 16) = vv; }
        const int tq = nb * 128 + wid * 16 + fr; const size_t tokq = tok0 + (size_t)d * tq;
        const bf16x8 q0 = *(const bf16x8*)(proj + tokq * INW + qcol + 8 * fq), q1 = *(const bf16x8*)(proj + tokq * INW + qcol + 32 + 8 * fq);
        __syncthreads();
        f32x4 s[9];
#pragma unroll
        for (int j = 0; j < 9; ++j) { const lds_u8* kp = Kt + (16 * (wid + j) + fr) * ATT_ROWB + fq * 16;
            const bf16x8 a0 = *(const LAS bf16x8*)kp, a1 = *(const LAS bf16x8*)(kp + 64);
            f32x4 z = (f32x4){0.f, 0.f, 0.f, 0.f}; z = __builtin_amdgcn_mfma_f32_16x16x32_bf16(a0, q0, z, 0, 0, 0); s[j] = __builtin_amdgcn_mfma_f32_16x16x32_bf16(a1, q1, z, 0, 0, 0); }
        float mx = -__builtin_inff();
#pragma unroll
        for (int j = 0; j < 9; ++j)
#pragma unroll
            for (int e = 0; e < 4; ++e) { const int delta = 128 + fr - 16 * j - 4 * fq - e; const int tk = (nb - 1) * 128 + 16 * (wid + j) + 4 * fq + e;
                const bool valid = (delta >= 0) && (delta <= max_off) && (tk >= 0);
                const float v = valid ? (s[j][e] * (0.125f * LOG2E) - slope2 * (float)delta) : -__builtin_inff(); s[j][e] = v; mx = fmaxf(mx, v); }
        mx = fmaxf(mx, __shfl_xor(mx, 16)); mx = fmaxf(mx, __shfl_xor(mx, 32)); mx = fmaxf(mx, sink2);
        float sum = 0.f;
#pragma unroll
        for (int j = 0; j < 9; ++j)
#pragma unroll
            for (int e = 0; e < 4; ++e) { const float p = __builtin_amdgcn_exp2f(s[j][e] - mx); s[j][e] = p; sum += p; }
        sum += __shfl_xor(sum, 16); sum += __shfl_xor(sum, 32); sum += __builtin_amdgcn_exp2f(sink2 - mx);
        bf16x8 pb[5];
#pragma unroll
        for (int ks = 0; ks < 5; ++ks) { u32x4 w; w.x = cvt_pk_bf16(s[2 * ks][0], s[2 * ks][1]); w.y = cvt_pk_bf16(s[2 * ks][2], s[2 * ks][3]);
            if (ks < 4) { w.z = cvt_pk_bf16(s[2 * ks + 1][0], s[2 * ks + 1][1]); w.w = cvt_pk_bf16(s[2 * ks + 1][2], s[2 * ks + 1][3]); } else { w.z = 0u; w.w = 0u; }
            pb[ks] = __builtin_bit_cast(bf16x8, w); }
        f32x4 o[4];
#pragma unroll
        for (int dt = 0; dt < 4; ++dt) { f32x4 z = (f32x4){0.f, 0.f, 0.f, 0.f};
#pragma unroll
            for (int ks = 0; ks < 5; ++ks) { const lds_u8* vp = Vt + (16 * (wid + 2 * ks) + 4 * fq + (fr >> 2)) * ATT_ROWB + (16 * dt + 4 * (fr & 3)) * 2;
                const s16x4 v0 = vtr(vp), v1 = vtr(vp + 16 * ATT_ROWB);
                const bf16x8 a = (bf16x8){v0[0], v0[1], v0[2], v0[3], v1[0], v1[1], v1[2], v1[3]};
                z = __builtin_amdgcn_mfma_f32_16x16x32_bf16(a, pb[ks], z, 0, 0, 0); }
            o[dt] = z; }
        const float inv = 1.0f / sum;
        bf16* orow = ((kind == 0) ? oA : oB + (size_t)(kind - 1) * M * 1024) + tokq * 1024 + h * 64 + 4 * fq;
#pragma unroll
        for (int dt = 0; dt < 4; ++dt) { u32x2 w; w.x = cvt_pk_bf16(o[dt][0] * inv, o[dt][1] * inv); w.y = cvt_pk_bf16(o[dt][2] * inv, o[dt][3] * inv); *(u32x2*)(orow + 16 * dt) = w; }
        if (kind > 0 && fq == 0) lseB[((size_t)(kind - 1) * M + tokq) * 16 + h] = mx + __builtin_amdgcn_logf(sum);
        __syncthreads();
    }
}

__device__ __forceinline__ void merge_phase(Frame& F, const bf16* oA, const bf16* oB, const float* lseB, const float* ga, const float* gb, bf16* mixed) {
    const int lane = F.lane, gw = F.bid * NWAVES + F.wave, NGW = F.G * NWAVES;
    f32x4 gA[4], gB[4];
#pragma unroll
    for (int jj = 0; jj < 2; ++jj) { gA[2 * jj] = *(const f32x4*)(ga + 512 * jj + 8 * lane); gA[2 * jj + 1] = *(const f32x4*)(ga + 512 * jj + 8 * lane + 4);
        gB[2 * jj] = *(const f32x4*)(gb + 512 * jj + 8 * lane); gB[2 * jj + 1] = *(const f32x4*)(gb + 512 * jj + 8 * lane + 4); }
    for (int t = gw; t < M; t += NGW) {
        f32x4 a[4], bb[4];
        float ssa = 0.f, ssb = 0.f;
#pragma unroll
        for (int jj = 0; jj < 2; ++jj) {
            const int e0 = 512 * jj + 8 * lane, hh = e0 >> 6;
            const u32x4 w = *(const u32x4*)(oA + (size_t)t * 1024 + e0);
            a[2 * jj] = (f32x4){bf_lo(w.x), bf_hi(w.x), bf_lo(w.y), bf_hi(w.y)}; a[2 * jj + 1] = (f32x4){bf_lo(w.z), bf_hi(w.z), bf_lo(w.w), bf_hi(w.w)};
            float l0 = lseB[((size_t)0 * M + t) * 16 + hh], l1 = lseB[((size_t)1 * M + t) * 16 + hh], l2 = lseB[((size_t)2 * M + t) * 16 + hh];
            const float lm = fmaxf(l0, fmaxf(l1, l2)); l0 = __builtin_amdgcn_exp2f(l0 - lm); l1 = __builtin_amdgcn_exp2f(l1 - lm); l2 = __builtin_amdgcn_exp2f(l2 - lm);
            const float li = 1.0f / (l0 + l1 + l2); l0 *= li; l1 *= li; l2 *= li;
            const u32x4 w0 = *(const u32x4*)(oB + ((size_t)0 * M + t) * 1024 + e0), w1 = *(const u32x4*)(oB + ((size_t)1 * M + t) * 1024 + e0), w2 = *(const u32x4*)(oB + ((size_t)2 * M + t) * 1024 + e0);
            bb[2 * jj] = (f32x4){bf_lo(w0.x), bf_hi(w0.x), bf_lo(w0.y), bf_hi(w0.y)} * l0 + (f32x4){bf_lo(w1.x), bf_hi(w1.x), bf_lo(w1.y), bf_hi(w1.y)} * l1 + (f32x4){bf_lo(w2.x), bf_hi(w2.x), bf_lo(w2.y), bf_hi(w2.y)} * l2;
            bb[2 * jj + 1] = (f32x4){bf_lo(w0.z), bf_hi(w0.z), bf_lo(w0.w), bf_hi(w0.w)} * l0 + (f32x4){bf_lo(w1.z), bf_hi(w1.z), bf_lo(w1.w), bf_hi(w1.w)} * l1 + (f32x4){bf_lo(w2.z), bf_hi(w2.z), bf_lo(w2.w), bf_hi(w2.w)} * l2;
        }
#pragma unroll
        for (int i = 0; i < 4; ++i) { ssa += (a[i][0] * a[i][0] + a[i][1] * a[i][1]) + (a[i][2] * a[i][2] + a[i][3] * a[i][3]); ssb += (bb[i][0] * bb[i][0] + bb[i][1] * bb[i][1]) + (bb[i][2] * bb[i][2] + bb[i][3] * bb[i][3]); }
        const float ra = 1.0f / sqrtf(wave_sum(ssa) * (1.0f / 1024.0f) + RMS_EPS), rb = 1.0f / sqrtf(wave_sum(ssb) * (1.0f / 1024.0f) + RMS_EPS);
#pragma unroll
        for (int jj = 0; jj < 2; ++jj) { const int e0 = 512 * jj + 8 * lane;
            const f32x4 x0 = a[2 * jj] * ra * gA[2 * jj], x1 = a[2 * jj + 1] * ra * gA[2 * jj + 1], y0 = bb[2 * jj] * rb * gB[2 * jj], y1 = bb[2 * jj + 1] * rb * gB[2 * jj + 1];
            u32x4 w; w.x = cvt_pk_bf16(x0[0], x0[1]); w.y = cvt_pk_bf16(x0[2], x0[3]); w.z = cvt_pk_bf16(x1[0], x1[1]); w.w = cvt_pk_bf16(x1[2], x1[3]);
            *(u32x4*)(mixed + (size_t)t * D + e0) = w;
            w.x = cvt_pk_bf16(y0[0], y0[1]); w.y = cvt_pk_bf16(y0[2], y0[3]); w.z = cvt_pk_bf16(y1[0], y1[1]); w.w = cvt_pk_bf16(y1[2], y1[3]);
            *(u32x4*)(mixed + (size_t)t * D + 1024 + e0) = w; }
    }
}

__device__ __forceinline__ void ln_phase(Frame& F, const float* y, const float* g, const float* b, float* hout, bf16* hb) {
    const int lane = F.lane, gw = F.bid * NWAVES + F.wave, NGW = F.G * NWAVES;
    Row rg, rb; row_load_f32(rg, g, lane); row_load_f32(rb, b, lane);
    for (int t = gw; t < M; t += NGW) { Row r; row_load_f32(r, y + (size_t)t * D, lane); row_layernorm(r, rg, rb); row_store_f32(r, hout + (size_t)t * D, lane); if (hb) row_store_bf16(r, hb + (size_t)t * D, lane); }
}

__device__ __forceinline__ void router_phase(Frame& F, const float* h, const float* wr_, const float* rbias, gu32* cnt, int* tok_e, int* tok_slot, float* tok_gate, int* row_tok, float* row_gate) {
    const int tid = F.tid, wid = F.wave, lane = F.lane, fr = lane & 15, fq = lane >> 4;
    LAS float* sc = (LAS float*)F.lds;
    LAS int* lcnt = (LAS int*)(F.lds + 17408);
    LAS int* gbase = (LAS int*)(F.lds + 17408 + 256);
    LAS int* ti_e = (LAS int*)(F.lds + 18432);
    LAS int* ti_ls = (LAS int*)(F.lds + 18432 + 2048);
    LAS float* ti_g = (LAS float*)(F.lds + 18432 + 4096);
    for (int i = F.bid * NWAVES * 64 + tid; i < NROWS; i += F.G * NWAVES * 64) { const bool sh = i >= RB_SHARED0 * 256; row_tok[i] = sh ? i - RB_SHARED0 * 256 : 0; row_gate[i] = sh ? 1.0f : 0.0f; }
    for (int grp = F.bid; grp < M / 64; grp += F.G) {
        if (tid < 64) lcnt[tid] = 0;
        if (wid < 4) {
            f32x4 acc[4];
#pragma unroll
            for (int n = 0; n < 4; ++n) acc[n] = (f32x4){0.f, 0.f, 0.f, 0.f};
            const float* xrow = h + (size_t)(grp * 64 + wid * 16 + fr) * D + 4 * fq;
#pragma unroll 2
            for (int kb = 0; kb < D; kb += 16) {
                const f32x4 a = *(const f32x4*)(xrow + kb);
#pragma unroll
                for (int s = 0; s < 4; ++s) { const f32x4 bq = *(const f32x4*)(wr_ + (size_t)(kb + 4 * fq + s) * NE + 4 * fr);
#pragma unroll
                    for (int n = 0; n < 4; ++n) acc[n] = __builtin_amdgcn_mfma_f32_16x16x4f32(a[s], bq[n], acc[n], 0, 0, 0); }
            }
#pragma unroll
            for (int n = 0; n < 4; ++n)
#pragma unroll
                for (int e = 0; e < 4; ++e) sc[(wid * 16 + 4 * fq + e) * 65 + 4 * fr + n] = acc[n][e];
        }
        __syncthreads();
        const float bias = rbias[lane];
        for (int ti = 0; ti < 8; ++ti) {
            const int tl = wid * 8 + ti;
            const float logit = sc[tl * 65 + lane];
            const float score = 1.0f / (1.0f + __expf(-logit));
            const float selv = score + bias;
            float m1 = selv;
#pragma unroll
            for (int o = 1; o < 8; o <<= 1) m1 = fmaxf(m1, __shfl_xor(m1, o));
            int i1 = (selv == m1) ? lane : 64;
#pragma unroll
            for (int o = 1; o < 8; o <<= 1) { const int x = __shfl_xor(i1, o); i1 = x < i1 ? x : i1; }
            float m2 = (lane == i1) ? -__builtin_inff() : selv;
#pragma unroll
            for (int o = 1; o < 8; o <<= 1) m2 = fmaxf(m2, __shfl_xor(m2, o));
            const float gs = m1 + m2; const int gi = lane >> 3;
            int rg = 0;
#pragma unroll
            for (int j = 0; j < 8; ++j) { const float og = __shfl(gs, 8 * j); rg += ((og > gs) || (og == gs && j < gi)) ? 1 : 0; }
            const bool gsel = rg < 4;
            const float mv = gsel ? selv : -__builtin_inff();
            int rk = 0;
#pragma unroll 4
            for (int j = 0; j < 64; ++j) { const float ov = __shfl(mv, j); rk += ((ov > mv) || (ov == mv && j < lane)) ? 1 : 0; }
            const bool chosen = gsel && (rk < TOPK);
            const float ssum = wave_sum(chosen ? score : 0.0f);
            if (chosen) { const int ls = __hip_atomic_fetch_add(lcnt + lane, 1, __ATOMIC_RELAXED, __HIP_MEMORY_SCOPE_WORKGROUP); ti_e[tl * 8 + rk] = lane; ti_ls[tl * 8 + rk] = ls; ti_g[tl * 8 + rk] = score / ssum * 2.5f; }
        }
        __syncthreads();
        if (tid < 64) gbase[tid] = (int)__hip_atomic_fetch_add((unsigned*)(cnt + tid), (unsigned)lcnt[tid], RLX_AGENT);
        __syncthreads();
        { const int e = ti_e[tid]; const size_t gi = (size_t)grp * 512 + tid; tok_e[gi] = e; tok_slot[gi] = gbase[e] + ti_ls[tid]; tok_gate[gi] = ti_g[tid]; }
        __syncthreads();
    }
}

__device__ __forceinline__ void scatter_phase(Frame& F, const gu32* cnt, const int* tok_e, const int* tok_slot, const float* tok_gate, int* tok_pos, int* row_tok, float* row_gate, int* meta) {
    LAS int* pstart = (LAS int*)F.lds;
    if (F.tid == 0) { int acc = 0; for (int e = 0; e < NE; ++e) { pstart[e] = acc; const int c = (int)__hip_atomic_load(cnt + e, RLX_AGENT); acc += (c + 255) >> 8; } pstart[NE] = acc; }
    __syncthreads();
    if (F.bid == 0) {
        if (F.tid == 0) meta[0] = pstart[NE];
        if (F.tid < NE) { for (int b = pstart[F.tid]; b < pstart[F.tid + 1]; ++b) meta[16 + b] = F.tid; }
    }
    for (int i = F.bid * NWAVES * 64 + F.tid; i < M * TOPK; i += F.G * NWAVES * 64) {
        const int e = tok_e[i], pos = pstart[e] * 256 + tok_slot[i];
        row_tok[pos] = i >> 3; row_gate[pos] = tok_gate[i]; tok_pos[i] = pos;
    }
}

__device__ __forceinline__ void combine_phase(Frame& F, const float* hres, const bf16* yrows, const int* tok_pos, const float* g, const float* b, float* hout, bf16* hb) {
    const int lane = F.lane, gw = F.bid * NWAVES + F.wave, NGW = F.G * NWAVES;
    Row rg, rb; row_load_f32(rg, g, lane); row_load_f32(rb, b, lane);
    for (int t = gw; t < M; t += NGW) {
        Row r; row_load_f32(r, hres + (size_t)t * D, lane);
#pragma unroll
        for (int i = 0; i < 8; ++i) r.v[i] = r.v[i] * ALPHA;
        int pos[8];
#pragma unroll
        for (int k = 0; k < 8; ++k) pos[k] = tok_pos[(size_t)t * 8 + k];
#pragma unroll
        for (int k = 0; k < 8; ++k) row_add_bf16(r, yrows + (size_t)pos[k] * D, lane);
        row_add_bf16(r, yrows + (size_t)(RB_SHARED0 * 256 + t) * D, lane);
        row_layernorm(r, rg, rb);
        row_store_f32(r, hout + (size_t)t * D, lane); if (hb) row_store_bf16(r, hb + (size_t)t * D, lane);
    }
}

constexpr int NPH_LAYER = 16, NPH = 2 + DEPTH * NPH_LAYER;
constexpr size_t SZ_WIN = (size_t)D * INW, SZ_DD = (size_t)D * D, SZ_EXP = (size_t)D * DE;

__global__ void __launch_bounds__(NWAVES * 64, 2) mk_fwd(Args args) {
    extern __shared__ __attribute__((aligned(16))) unsigned char lds_raw[];
    Frame F;
    F.lds = (lds_u8*)lds_raw; F.MISC = (volatile LAS unsigned*)(F.lds + MISC_OFF);
    F.tid = threadIdx.x; F.lane = F.tid & 63; F.wave = __builtin_amdgcn_readfirstlane(F.tid >> 6); F.G = gridDim.x; F.bid = blockIdx.x;
    F.ctl = (gu32*)(WSP + WS_CTL);
    if (F.tid < 64) F.MISC[F.tid] = 0u;
    __syncthreads();
    const int lo = args.ph_lo, hi = args.ph_hi;
    const bool use_bar = (hi - lo) > 1;
    XcdBarrier bar; bar.bar = (unsigned*)(F.ctl + CW_BAR); bar.x = 0; bar.st = nullptr;
    if (use_bar) bar = xcd_barrier_post((unsigned*)(F.ctl + CW_BAR), F.MISC + 8);
#define IN(k) (lo <= (k) && (k) < hi)
#define SEAM(k) do { if (IN(k) && IN((k) + 1)) xcd_barrier(bar); } while (0)

#define xin ((const float*)INP(0))
#define memb ((bf16*)(WSP + WS_MEMB))
#define Kc ((bf16*)(WSP + WS_KC))
#define VT ((bf16*)(WSP + WS_VT))
#define WinT ((bf16*)(WSP + WS_WIN))
#define WoutT ((bf16*)(WSP + WS_WOUT))
#define WqT ((bf16*)(WSP + WS_WQ))
#define WoT ((bf16*)(WSP + WS_WO))
#define WguT ((bf16*)(WSP + WS_WGU))
#define WdT ((bf16*)(WSP + WS_WD))
#define hbuf ((float*)(WSP + WS_H))
#define hb ((bf16*)(WSP + WS_HB))
#define ybuf ((float*)(WSP + WS_Y))
#define proj ((bf16*)(WSP + WS_PROJ))
#define oA ((bf16*)(WSP + WS_OA))
#define oB ((bf16*)(WSP + WS_OB))
#define lseB ((float*)(WSP + WS_LSE))
#define mixed ((bf16*)(WSP + WS_MIXED))
#define qb ((bf16*)(WSP + WS_Q))
#define Pb ((bf16*)(WSP + WS_P))
#define ob ((bf16*)(WSP + WS_O))
#define WkT ((bf16*)(WSP + WS_WKT))
#define WvT ((bf16*)(WSP + WS_WVT))
#define hid ((bf16*)(WSP + WS_HID))
#define yrows ((bf16*)(WSP + WS_YROWS))
#define meta ((int*)(WSP + WS_META))
#define tok_e ((int*)(WSP + WS_TOKE))
#define tok_slot ((int*)(WSP + WS_TOKSLOT))
#define tok_gate ((float*)(WSP + WS_TOKGATE))
#define tok_pos ((int*)(WSP + WS_TOKPOS))
#define row_tok ((int*)(WSP + WS_ROWTOK))
#define row_gate ((float*)(WSP + WS_ROWGATE))

    if (KIND_EN(0) && IN(0)) { relaunder(F);
        const int gw = F.bid * NWAVES + F.wave, NGW = F.G * NWAVES; LAS float* scr = (LAS float*)(F.lds + F.wave * 16640);
        { const float* xp = xin; bf16* hbp = hb;
        for (size_t i = (size_t)F.bid * NWAVES * 64 + F.tid; i < (size_t)M * D / 8; i += (size_t)F.G * NWAVES * 64) {
            const f32x4 a = *(const f32x4*)(xp + i * 8), b = *(const f32x4*)(xp + i * 8 + 4);
            u32x4 w; w.x = cvt_pk_bf16(a[0], a[1]); w.y = cvt_pk_bf16(a[2], a[3]); w.z = cvt_pk_bf16(b[0], b[1]); w.w = cvt_pk_bf16(b[2], b[3]); *(u32x4*)(hbp + i * 8) = w; } }
        { const float* mem = INP(1); bf16* mb = memb;
        for (size_t i = (size_t)F.bid * NWAVES * 64 + F.tid; i < (size_t)NBATCH * 256 * D / 8; i += (size_t)F.G * NWAVES * 64) {
            const f32x4 a = *(const f32x4*)(mem + i * 8), b = *(const f32x4*)(mem + i * 8 + 4);
            u32x4 w; w.x = cvt_pk_bf16(a[0], a[1]); w.y = cvt_pk_bf16(a[2], a[3]); w.z = cvt_pk_bf16(b[0], b[1]); w.w = cvt_pk_bf16(b[2], b[3]); *(u32x4*)(mb + i * 8) = w; } }
        { const float* wk = INP(10); const float* wv = INP(11); bf16* wkt = WkT; bf16* wvt = WvT;
        for (int it = gw; it < 4096; it += NGW) { const int mat = it >> 10, sub = it & 1023, l = mat & 1;
            const float* W = (mat < 2 ? wk : wv) + (size_t)l * SZ_DD;
            tr_matrix_item<false>(W, D, D, mat < 2 ? wkt : wvt, (size_t)l * D, sub, scr, F.lane); } }
    }
    SEAM(0);
    if (KIND_EN(1) && IN(1)) { relaunder(F);
        { pg8::ProbStatic P{(const char*)memb, (const char*)WkT, D, D, D, (size_t)256 * D * 2, 0, 0, (size_t)256 * D * 2, 0, 1, {}}; P.S.init(4, 16, F.G, F.bid);
          pg8::EpiBf16 E{Kc, 2 * D, 1.0f}; pg8::gemm_phase<pg8::EpiBf16, pg8::ProbStatic, false>(F.lds, P, E, F.tid); }
        { pg8::ProbStatic P{(const char*)WvT, (const char*)memb, D, D, D, (size_t)256 * D * 2, 0, 0, (size_t)256 * D * 2, 0, 1, {}}; P.S.init(16, 4, F.G, (F.bid + F.G / 2) % F.G);
          pg8::EpiBf16 E{VT, 1024, 1.0f}; pg8::gemm_phase<pg8::EpiBf16, pg8::ProbStatic, false>(F.lds, P, E, F.tid); }
    }
    SEAM(1);

    for (int l = 0; l < DEPTH; ++l) {
        const int pb = 2 + NPH_LAYER * l;
        const float* hres = (l == 0) ? xin : hbuf;
        if (KIND_EN(2) && IN(pb + 0)) { relaunder(F);
            const int gw = F.bid * NWAVES + F.wave, NGW = F.G * NWAVES; LAS float* scr = (LAS float*)(F.lds + F.wave * 16640);
            const float* w_in = INP(2) + (size_t)l * SZ_WIN; const float* w_out = INP(6) + (size_t)l * SZ_DD;
            const float* wq = INP(9) + (size_t)l * SZ_DD; const float* wo = INP(12) + (size_t)l * SZ_DD;
            const float* wg = INP(17) + (size_t)l * NE * SZ_EXP; const float* wu = INP(18) + (size_t)l * NE * SZ_EXP; const float* wd = INP(19) + (size_t)l * NE * SZ_EXP;
            const float* wsg = INP(20) + (size_t)l * SZ_EXP; const float* wsu = INP(21) + (size_t)l * SZ_EXP; const float* wsd = INP(22) + (size_t)l * SZ_EXP;
            bf16* pWin = WinT; bf16* pWout = WoutT; bf16* pWq = WqT; bf16* pWo = WoT; bf16* pWgu = WguT; bf16* pWd = WdT;
            constexpr int I_IN = 32 * 68, I_DD = 1024, I_E = 256, NIT = I_IN + 3 * I_DD + 3 * 65 * I_E;
            for (int it = gw; it < NIT; it += NGW) {
                int r = it;
                if (r < I_IN) { tr_matrix_item<false>(w_in, D, INW, pWin, 0, r, scr, F.lane); continue; } r -= I_IN;
                if (r < I_DD) { tr_matrix_item<false>(w_out, D, D, pWout, 0, r, scr, F.lane); continue; } r -= I_DD;
                if (r < I_DD) { tr_matrix_item<false>(wq, D, D, pWq, 0, r, scr, F.lane); continue; } r -= I_DD;
                if (r < I_DD) { tr_matrix_item<false>(wo, D, D, pWo, 0, r, scr, F.lane); continue; } r -= I_DD;
                if (r < 65 * I_E) { const int e = r >> 8; tr_matrix_item<true>(e < NE ? wg + (size_t)e * SZ_EXP : wsg, D, DE, pWgu + (size_t)e * 1024 * D, 0, r & 255, scr, F.lane); continue; } r -= 65 * I_E;
                if (r < 65 * I_E) { const int e = r >> 8; tr_matrix_item<true>(e < NE ? wu + (size_t)e * SZ_EXP : wsu, D, DE, pWgu + (size_t)e * 1024 * D, 128, r & 255, scr, F.lane); continue; } r -= 65 * I_E;
                { const int e = r >> 8; tr_matrix_item<false>(e < NE ? wd + (size_t)e * SZ_EXP : wsd, DE, D, pWd + (size_t)e * D * DE, 0, r & 255, scr, F.lane); }
            }
        }
        SEAM(pb + 0);
        if (KIND_EN(3) && IN(pb + 1)) { relaunder(F);
            pg8::ProbStatic P{(const char*)hb, (const char*)WinT, D, D, D, (size_t)256 * D * 2, 0, 0, (size_t)256 * D * 2, 0, 1, {}}; P.S.init(M / 256, INW / 256, F.G, F.bid);
            pg8::EpiBf16 E{proj, INW, 1.0f}; pg8::gemm_phase<pg8::EpiBf16, pg8::ProbStatic, true>(F.lds, P, E, F.tid);
        }
        SEAM(pb + 1);
        if (KIND_EN(4) && IN(pb + 2)) { relaunder(F); attn_phase(F, proj, INP(3) + l * 16, oA, oB, lseB); }
        SEAM(pb + 2);
        if (KIND_EN(5) && IN(pb + 3)) { relaunder(F); merge_phase(F, oA, oB, lseB, INP(4) + l * 1024, INP(5) + l * 1024, mixed); }
        SEAM(pb + 3);
        if (KIND_EN(6) && IN(pb + 4)) { relaunder(F);
            pg8::ProbStatic P{(const char*)mixed, (const char*)WoutT, D, D, D, (size_t)256 * D * 2, 0, 0, (size_t)256 * D * 2, 0, 1, {}}; P.S.init(M / 256, D / 256, F.G, F.bid);
            pg8::EpiResF32 E{hres, ybuf, D, ALPHA}; pg8::gemm_phase<pg8::EpiResF32, pg8::ProbStatic, true>(F.lds, P, E, F.tid);
        }
        SEAM(pb + 4);
        if (KIND_EN(7) && IN(pb + 5)) { relaunder(F); ln_phase(F, ybuf, INP(7) + l * D, INP(8) + l * D, hbuf, hb); }
        SEAM(pb + 5);
        if (KIND_EN(8) && IN(pb + 6)) { relaunder(F);
            pg8::ProbStatic P{(const char*)hb, (const char*)WqT, D, D, D, (size_t)256 * D * 2, 0, 0, (size_t)256 * D * 2, 0, 1, {}}; P.S.init(M / 256, D / 256, F.G, F.bid);
            pg8::EpiBf16 E{qb, D, 1.0f}; pg8::gemm_phase<pg8::EpiBf16, pg8::ProbStatic, true>(F.lds, P, E, F.tid);
        }
        SEAM(pb + 6);
        if (KIND_EN(9) && IN(pb + 7)) { relaunder(F);
            pg8::ProbStatic P{(const char*)qb, (const char*)(Kc + (size_t)l * D), D, 2 * D, 512, (size_t)256 * D * 2, (size_t)512 * 2, 0, (size_t)512 * 2, (size_t)256 * 2 * D * 2, 16, {}}; P.S.init(M / 256, 4, F.G, F.bid);
            pg8::EpiSoftmax E{Pb, 1024, 0.044194173824159216f * LOG2E}; pg8::gemm_phase<pg8::EpiSoftmax, pg8::ProbStatic, false>(F.lds, P, E, F.tid);
        }
        SEAM(pb + 7);
        if (KIND_EN(10) && IN(pb + 8)) { relaunder(F);
            pg8::ProbStatic P{(const char*)Pb, (const char*)(VT + (size_t)l * D * 1024), 1024, 1024, 256, (size_t)256 * 1024 * 2, (size_t)256 * 2, 1, (size_t)256 * 1024 * 2, (size_t)256 * 2, 16, {}}; P.S.init(M / 256, 8, F.G, F.bid);
            pg8::EpiBf16 E{ob, D, 1.0f}; pg8::gemm_phase<pg8::EpiBf16, pg8::ProbStatic, true>(F.lds, P, E, F.tid);
        }
        SEAM(pb + 8);
        if (KIND_EN(11) && IN(pb + 9)) { relaunder(F);
            pg8::ProbStatic P{(const char*)ob, (const char*)WoT, D, D, D, (size_t)256 * D * 2, 0, 0, (size_t)256 * D * 2, 0, 1, {}}; P.S.init(M / 256, D / 256, F.G, F.bid);
            pg8::EpiResF32 E{hbuf, ybuf, D, ALPHA}; pg8::gemm_phase<pg8::EpiResF32, pg8::ProbStatic, true>(F.lds, P, E, F.tid);
        }
        SEAM(pb + 9);
        if (KIND_EN(12) && IN(pb + 10)) { relaunder(F); ln_phase(F, ybuf, INP(13) + l * D, INP(14) + l * D, hbuf, hb); }
        SEAM(pb + 10);
        if (KIND_EN(13) && IN(pb + 11)) { relaunder(F); router_phase(F, hbuf, INP(15) + (size_t)l * D * NE, INP(16) + l * NE, F.ctl + CW_CNT + l * 64, tok_e, tok_slot, tok_gate, row_tok, row_gate); }
        SEAM(pb + 11);
        if (KIND_EN(14) && IN(pb + 12)) { relaunder(F); scatter_phase(F, F.ctl + CW_CNT + l * 64, tok_e, tok_slot, tok_gate, tok_pos, row_tok, row_gate, meta); }
        SEAM(pb + 12);
        if (KIND_EN(15) && IN(pb + 13)) { relaunder(F);
            LAS int* blkexp = (LAS int*)(F.lds + BLKEXP_OFF); LAS int* tokbuf = (LAS int*)(F.lds + TOKBUF_OFF); LAS float* gatebuf = (LAS float*)(F.lds + GATEBUF_OFF);
            const int nblk = meta[0];
            for (int i = F.tid; i < 640; i += NWAVES * 64) blkexp[i] = (i < nblk) ? meta[16 + i] : NE;
            __syncthreads();
            const int ntot = (nblk + 64) * 4;
            pg8::ProbMoe<true> P{(const char*)hb, (const char*)WguT, D, D, D, 4, (size_t)1024 * D * 2, (size_t)256 * D * 2, blkexp, tokbuf, nblk, ntot, (ntot + 7) / 8, F.bid & 7, F.bid >> 3, F.G >> 3};
            for (int i = 0; i < MAXORD; ++i) { pg8::Unit u; if (!P.next(i, u)) break;
                if (F.tid < 256) tokbuf[i * 256 + F.tid] = row_tok[u.pm * 256 + F.tid]; else gatebuf[i * 256 + F.tid - 256] = row_gate[u.pm * 256 + F.tid - 256]; }
            __syncthreads();
            pg8::EpiSwiGLU E{hid, gatebuf}; pg8::gemm_phase<pg8::EpiSwiGLU, pg8::ProbMoe<true>, true>(F.lds, P, E, F.tid);
        }
        SEAM(pb + 13);
        if (KIND_EN(16) && IN(pb + 14)) { relaunder(F);
            LAS int* blkexp = (LAS int*)(F.lds + BLKEXP_OFF);
            const int nblk = meta[0];
            for (int i = F.tid; i < 640; i += NWAVES * 64) blkexp[i] = (i < nblk) ? meta[16 + i] : NE;
            __syncthreads();
            const int ntot = (nblk + 64) * 8;
            pg8::ProbMoe<false> P{(const char*)hid, (const char*)WdT, DE, DE, DE, 8, (size_t)D * DE * 2, (size_t)256 * DE * 2, blkexp, nullptr, nblk, ntot, (ntot + 7) / 8, F.bid & 7, F.bid >> 3, F.G >> 3};
            pg8::EpiBf16 E{yrows, D, 1.0f}; pg8::gemm_phase<pg8::EpiBf16, pg8::ProbMoe<false>, true>(F.lds, P, E, F.tid);
        }
        SEAM(pb + 14);
        if (KIND_EN(17) && IN(pb + 15)) { relaunder(F); combine_phase(F, hbuf, yrows, tok_pos, INP(23) + l * D, INP(24) + l * D, (l == DEPTH - 1) ? OUTP : hbuf, (l == DEPTH - 1) ? nullptr : hb); }
        if (l + 1 < DEPTH) SEAM(pb + 15);
    }
    if (use_bar && hi == NPH) {
        if (__hip_atomic_load(F.ctl + CW_BAR + XB_TMO, RLX_AGENT) != 0u && F.tid == 0) { VM_WAIT(); OUTP[(size_t)F.bid * D] = __builtin_nanf(""); }
    }
#undef IN
#undef SEAM
}

extern "C" void kernel_launch(void* const* d_in, const int* in_sizes, int n_in, void* d_out, int out_size, void* d_ws, size_t ws_size, hipStream_t stream) {
    static int grid = 0;
    if (grid == 0) {
        if (n_in != 25 || in_sizes[0] != M * D || out_size != M * D || ws_size < WS_END) { fprintf(stderr, "kernel_launch: unexpected shapes (n_in %d, in0 %d, out %d, ws %zu, need %zu); nothing launched\n", n_in, n_in > 0 ? in_sizes[0] : -1, out_size, ws_size, (size_t)WS_END); grid = -1; return; }
        int dev = 0, cus = 0, per_cu = 0;
        if (hipGetDevice(&dev) != hipSuccess || hipDeviceGetAttribute(&cus, hipDeviceAttributeMultiprocessorCount, dev) != hipSuccess) { grid = -1; return; }
        if (hipFuncSetAttribute((const void*)mk_fwd, hipFuncAttributeMaxDynamicSharedMemorySize, LDS_BYTES) != hipSuccess) { fprintf(stderr, "kernel_launch: hipFuncSetAttribute failed\n"); grid = -1; return; }
        if (hipOccupancyMaxActiveBlocksPerMultiprocessor(&per_cu, (const void*)mk_fwd, NWAVES * 64, LDS_BYTES) != hipSuccess || per_cu < 1) fprintf(stderr, "kernel_launch: occupancy query reports %d\n", per_cu);
        (void)hipGetLastError();
        grid = cus;
        if (grid != 256) { fprintf(stderr, "kernel_launch: built for 256 CUs, device has %d; nothing launched\n", cus); grid = -1; return; }
    }
    if (grid < 0) return;
    if (hipMemsetAsync((char*)d_ws + WS_CTL, 0, CTL_ZERO_BYTES, stream) != hipSuccess) return;
    Args a{};
    for (int i = 0; i < 25; ++i) a.in[i] = (const float*)d_in[i];
    a.out = (float*)d_out; a.ws = (unsigned char*)d_ws;
#if MK_N_LAUNCHES == 1
    a.ph_lo = 0; a.ph_hi = NPH;
    hipLaunchKernelGGL(mk_fwd, dim3(grid), dim3(NWAVES * 64), LDS_BYTES, stream, a);
#else
    for (int p = 0; p < NPH; ++p) { a.ph_lo = p; a.ph_hi = p + 1; hipLaunchKernelGGL(mk_fwd, dim3(grid), dim3(NWAVES * 64), LDS_BYTES, stream, a); }
#endif
}
```

```cpp
#include <hip/hip_runtime.h>
#include <cstdio>
#include <cstdint>

#ifndef MK_N_LAUNCHES
#define MK_N_LAUNCHES 1
#endif
#ifndef MK_KINDS
#define MK_KINDS 0x3ffff
#endif
#define KIND_EN(k) (((MK_KINDS) >> (k)) & 1)
#ifndef MK_REP_MASK
#define MK_REP_MASK 0
#endif
#define NREP(k) (1 + (((MK_REP_MASK) >> (k)) & 1))

#define GAS __attribute__((address_space(1)))
#define LAS __attribute__((address_space(3)))
typedef unsigned short bf16;
typedef short bf16x8 __attribute__((ext_vector_type(8)));
typedef short s16x4 __attribute__((ext_vector_type(4)));
typedef float f32x4 __attribute__((ext_vector_type(4)));
typedef float f32x2 __attribute__((ext_vector_type(2)));
typedef unsigned u32x4 __attribute__((ext_vector_type(4)));
typedef unsigned u32x2 __attribute__((ext_vector_type(2)));
typedef LAS unsigned char lds_u8;
typedef GAS unsigned gu32;

constexpr int D = 2048, NBATCH = 4, SEQ = 4096, M = NBATCH * SEQ, DEPTH = 2;
constexpr int INW = 4352;
constexpr int NE = 64, TOPK = 8, DE = 512;
constexpr float ALPHA = 1.4142135623730951f;
constexpr float LN_EPS = 1e-5f, RMS_EPS = 1e-6f;
constexpr float LOG2E = 1.4426950408889634f;
constexpr int RB_SHARED0 = 576;
constexpr int NROWS = (RB_SHARED0 + 64) * 256;
constexpr int MAXORD = 12;

constexpr size_t MiB = 1u << 20;
constexpr size_t WS_CTL = 0, CTL_ZERO_BYTES = 1 * MiB;
constexpr size_t WS_META = 1 * MiB;
constexpr size_t WS_TOKE = 2 * MiB, WS_TOKSLOT = 2 * MiB + 512 * 1024, WS_TOKGATE = 3 * MiB, WS_TOKPOS = 3 * MiB + 512 * 1024;
constexpr size_t WS_ROWTOK = 4 * MiB, WS_ROWGATE = 5 * MiB;
constexpr size_t WS_MEMB = 6 * MiB, WS_KC = 10 * MiB, WS_VT = 18 * MiB;
constexpr size_t WS_WIN = 26 * MiB, WS_WOUT = 43 * MiB, WS_WQ = 51 * MiB, WS_WO = 59 * MiB, WS_WGU = 67 * MiB, WS_WD = 327 * MiB;
constexpr size_t WS_H = 457 * MiB, WS_HB = 585 * MiB, WS_Y = 649 * MiB, WS_R = 777 * MiB;
constexpr size_t WS_PROJ = WS_R, WS_OA = WS_R + 136 * MiB, WS_OB = WS_R + 168 * MiB, WS_LSE = WS_R + 264 * MiB, WS_MIXED = WS_R + 267 * MiB;
constexpr size_t WS_Q = WS_R + 331 * MiB, WS_P = WS_R + 395 * MiB, WS_O = WS_R + 427 * MiB;
constexpr size_t WS_WKT = WS_R, WS_WVT = WS_R + 16 * MiB;
constexpr size_t WS_HID = WS_R, WS_YROWS = WS_R + 160 * MiB;
constexpr size_t WS_END = WS_R + 800 * MiB;
constexpr int CW_TMO = 0, CW_CODE = 1;
constexpr int CW_BAR = 4096;
constexpr int CW_CNT = 16384;

constexpr int RING_BYTES = 131072;
constexpr int AUX_OFF = RING_BYTES;
constexpr int TOKBUF_OFF = AUX_OFF, GATEBUF_OFF = AUX_OFF + MAXORD * 1024, BLKEXP_OFF = GATEBUF_OFF + MAXORD * 1024;
constexpr int MISC_OFF = BLKEXP_OFF + 2560;
constexpr int LDS_BYTES = MISC_OFF + 256;
static_assert(LDS_BYTES <= 160 * 1024 && (MISC_OFF % 16) == 0, "LDS map");

#define RLX_AGENT __ATOMIC_RELAXED, __HIP_MEMORY_SCOPE_AGENT
#define LDS_WAIT() asm volatile("s_waitcnt lgkmcnt(0)" ::: "memory")
#define VM_WAIT() asm volatile("s_waitcnt vmcnt(0)" ::: "memory")
__device__ __forceinline__ unsigned cvt_pk_bf16(float lo, float hi) { unsigned r; asm volatile("v_cvt_pk_bf16_f32 %0, %1, %2" : "=v"(r) : "v"(lo), "v"(hi)); return r; }
__device__ __forceinline__ float bf_lo(unsigned w) { return __uint_as_float(w << 16); }
__device__ __forceinline__ float bf_hi(unsigned w) { return __uint_as_float(w & 0xffff0000u); }
__device__ __forceinline__ float wave_sum(float v) {
#pragma unroll
    for (int o = 1; o < 64; o <<= 1) v += __shfl_xor(v, o);
    return v;
}

#define XB_TMO      128
#define XB_XCNT(j)  (256  + 64 * (j))
#define XB_XSUB(j)  (1280 + 64 * (j))
#define XB_XGEN(j)  (2304 + 64 * (j))
#define XB_TOP      3328
#define XB_TOPGEN   3392
#define XCD_BAR_WORDS 3456
#define XB_SPIN_CAP (1u << 18)
__device__ __forceinline__ unsigned xb_ld(unsigned* p)              { return __hip_atomic_load(p, __ATOMIC_RELAXED, __HIP_MEMORY_SCOPE_AGENT); }
__device__ __forceinline__ unsigned xb_add(unsigned* p, unsigned v) { return __hip_atomic_fetch_add(p, v, __ATOMIC_RELAXED, __HIP_MEMORY_SCOPE_AGENT); }
__device__ __forceinline__ unsigned xb_xcc_id() { return (unsigned)__builtin_amdgcn_s_getreg((3 << 11) | 20) & 0xFu; }
#define XB_SPIN(cond, bar) do { unsigned _sp = 0; while (cond) { __builtin_amdgcn_s_sleep(1); \
    if ((++_sp & 255u) == 0u) { if (xb_ld(&(bar)[XB_TMO])) break; if (_sp > XB_SPIN_CAP) { atomicAdd(&(bar)[XB_TMO], 1u); break; } } } } while (0)
struct XcdBarrier { unsigned* bar; unsigned x; volatile LAS unsigned* st; };
__device__ __forceinline__ XcdBarrier xcd_barrier_post(unsigned* bar, volatile LAS unsigned* st) {
    XcdBarrier b; b.bar = bar; b.x = xb_xcc_id(); b.st = st;
    if (threadIdx.x == 0) (void)xb_add(&bar[XB_XCNT(b.x)], 1u);
    return b;
}
__device__ __forceinline__ void xcd_barrier_complete(unsigned* bar, unsigned x, unsigned& nloc, unsigned& nx) {
    const unsigned G = gridDim.x * gridDim.y * gridDim.z;
    unsigned sum, cnt, mine, sp = 0u;
    for (;;) {
        sum = 0u; cnt = 0u; mine = 0u;
#pragma unroll
        for (unsigned j = 0; j < 16; ++j) { const unsigned c = xb_ld(&bar[XB_XCNT(j)]); sum += c; cnt += (c > 0u) ? 1u : 0u; mine = (j == x) ? c : mine; }
        if (sum == G) break;
        __builtin_amdgcn_s_sleep(1);
        if ((++sp & 255u) == 0u) { if (xb_ld(&bar[XB_TMO])) break; if (sp > XB_SPIN_CAP) { atomicAdd(&bar[XB_TMO], 1u); break; } }
    }
    nloc = mine > 0u ? mine : 1u; nx = cnt > 0u ? cnt : 1u;
}
__device__ __forceinline__ void xcd_barrier(const XcdBarrier& b) {
    asm volatile("s_waitcnt vmcnt(0)" ::: "memory");
    __syncthreads();
    if (threadIdx.x == 0) {
        unsigned* bar = b.bar;
        __builtin_amdgcn_s_waitcnt(0);
        unsigned nloc = b.st[0], nx = b.st[1];
        if (nloc == 0u) { xcd_barrier_complete(bar, b.x, nloc, nx); b.st[0] = nloc; b.st[1] = nx; }
        const unsigned old = xb_add(&bar[XB_XSUB(b.x)], 1u);
        const unsigned gen = old / nloc;
        if (old + 1u == (gen + 1u) * nloc) {
            __builtin_amdgcn_fence(__ATOMIC_RELEASE, "agent");
            asm volatile("s_waitcnt vmcnt(0)" ::: "memory");
            const unsigned og = xb_add(&bar[XB_TOP], 1u);
            const unsigned tg = og / nx;
            if (og + 1u == (tg + 1u) * nx) xb_add(&bar[XB_TOPGEN], 1u);
            else XB_SPIN(xb_ld(&bar[XB_TOPGEN]) == tg, bar);
            __builtin_amdgcn_fence(__ATOMIC_ACQUIRE, "agent");
            xb_add(&bar[XB_XGEN(b.x)], 1u);
            asm volatile("s_waitcnt vmcnt(0)" ::: "memory");
        } else {
            XB_SPIN(xb_ld(&bar[XB_XGEN(b.x)]) == gen, bar);
            __builtin_amdgcn_fence(__ATOMIC_ACQUIRE, "agent");
            asm volatile("s_waitcnt vmcnt(0)" ::: "memory");
        }
    }
    __syncthreads();
}

namespace pg8 {
constexpr int BM = 256, BK = 64, HALF = 128, HTB = HALF * BK * 2, STAGE_BYTES = 8 * HTB, NXCD = 8, WGM = 8;
__host__ __device__ __forceinline__ int lds_byte(int r, int c) { const int st = (r >> 4) * 2 + (c >> 5), rr = r & 15, cc = c & 31, ob = rr * 64 + cc * 2; return st * 1024 + (ob ^ (((ob >> 9) & 1) << 5)); }
__host__ __device__ __forceinline__ void stage_rc(int b, int& R, int& C) { const int st = b / 1024, sb = b % 1024, swz = sb ^ (((sb >> 9) & 1) << 5); R = (st >> 1) * 16 + swz / 64; C = (st & 1) * 32 + (swz % 64) / 2; }
__host__ __device__ __forceinline__ int perm32(int rho) { const int n = rho >> 4, i = rho & 15; return 8 * (i >> 2) + 4 * n + (i & 3); }

struct Unit { int pm, pn, ex, ord; };

struct StaticOrder {
    int nM, nN, nwg, G, c;
    __device__ void init(int nM_, int nN_, int G_, int c_) { nM = nM_; nN = nN_; nwg = nM * nN; G = G_; c = c_; }
    __device__ bool next(int i, Unit& u) const {
        const long L = (long)i * G + c; if (L >= nwg) return false;
        int wgid = (int)L; { const int q = nwg / NXCD, r = nwg % NXCD, xcd = wgid % NXCD, off = wgid / NXCD; wgid = (xcd < r ? xcd * (q + 1) : r * (q + 1) + (xcd - r) * q) + off; }
        const int nig = WGM * nN, gid = wgid / nig, fm = gid * WGM, gsz = (nM - fm) < WGM ? (nM - fm) : WGM;
        u.pm = fm + ((wgid % nig) % gsz); u.pn = (wgid % nig) / gsz; u.ex = 0; u.ord = i; return true;
    }
};

struct ProbStatic {
    const char* A0; const char* B0; int lda, ldb, K;
    size_t a_pm_step, a_pn_step; int a_pn_shift; size_t b_pn_step, b_batch_step; int batch_div;
    StaticOrder S;
    __device__ __forceinline__ bool next(int i, Unit& u) const { return S.next(i, u); }
    __device__ __forceinline__ const char* a_base(const Unit& u) const { return A0 + (size_t)u.pm * a_pm_step + (size_t)(u.pn >> a_pn_shift) * a_pn_step; }
    __device__ __forceinline__ const char* b_base(const Unit& u) const { return B0 + (size_t)u.pn * b_pn_step + (size_t)(u.pm / batch_div) * b_batch_step; }
    __device__ __forceinline__ void a_offs(const Unit&, const int (&R)[2], const int (&C)[2], unsigned (&vo)[2][2]) const {
#pragma unroll
        for (int h = 0; h < 2; ++h)
#pragma unroll
            for (int i = 0; i < 2; ++i) vo[h][i] = (unsigned)((R[i] + HALF * h) * lda + C[i]) * 2u;
    }
};

template <bool GATHER> struct ProbMoe {
    const char* A0; const char* B0; int lda, ldb, K, npn; size_t b_e_step, b_pn_step;
    const LAS int* blkexp; const LAS int* tokbuf; int nblk, ntot, chunk, xcd, rank, nrank;
    __device__ __forceinline__ bool next(int i, Unit& u) const {
        const int idx = xcd * chunk + i * nrank + rank; int lim = (xcd + 1) * chunk; lim = lim < ntot ? lim : ntot;
        if (idx >= lim || i * nrank + rank >= chunk) return false;
        const int lb = idx / npn; u.pn = idx - lb * npn;
        if (lb < nblk) { u.pm = lb; u.ex = blkexp[lb]; } else { u.pm = RB_SHARED0 + (lb - nblk); u.ex = NE; }
        u.ord = i; return true;
    }
    __device__ __forceinline__ const char* a_base(const Unit& u) const { return GATHER ? A0 : A0 + (size_t)u.pm * BM * lda * 2; }
    __device__ __forceinline__ const char* b_base(const Unit& u) const { return B0 + (size_t)u.ex * b_e_step + (size_t)u.pn * b_pn_step; }
    __device__ __forceinline__ void a_offs(const Unit& u, const int (&R)[2], const int (&C)[2], unsigned (&vo)[2][2]) const {
#pragma unroll
        for (int h = 0; h < 2; ++h)
#pragma unroll
            for (int i = 0; i < 2; ++i) {
                if (GATHER) { const int tok = tokbuf[u.ord * 256 + R[i] + HALF * h]; vo[h][i] = (unsigned)(tok * lda + C[i]) * 2u; }
                else vo[h][i] = (unsigned)((R[i] + HALF * h) * lda + C[i]) * 2u;
            }
    }
};

struct EpiBf16 {
    static constexpr bool PERM = true, AFTER_DRAIN = false;
    bf16* O; int ldc; float scale;
    __device__ __forceinline__ void operator()(const f32x4 (&acc)[2][2][4][2], const Unit& u, int wr, int wc, int fr, int fq) const {
        const int row0 = u.pm * BM + wr * 64 + fr, col0 = u.pn * BM + wc * 32 + 8 * fq;
#pragma unroll
        for (int ai = 0; ai < 2; ++ai)
#pragma unroll
            for (int m = 0; m < 4; ++m) { bf16* rowp = O + (size_t)(row0 + ai * HALF + m * 16) * ldc + col0;
#pragma unroll
                for (int bj = 0; bj < 2; ++bj) { const f32x4 v0 = acc[ai][bj][m][0] * scale, v1 = acc[ai][bj][m][1] * scale;
                    u32x4 w; w.x = cvt_pk_bf16(v0[0], v0[1]); w.y = cvt_pk_bf16(v0[2], v0[3]); w.z = cvt_pk_bf16(v1[0], v1[1]); w.w = cvt_pk_bf16(v1[2], v1[3]);
                    *(u32x4*)(rowp + bj * HALF) = w; } }
    }
};
struct EpiResF32 {
    static constexpr bool PERM = false, AFTER_DRAIN = false;
    const float* base; float* Y; int ldc; float alpha;
    __device__ __forceinline__ void operator()(const f32x4 (&acc)[2][2][4][2], const Unit& u, int wr, int wc, int fr, int fq) const {
        const int row0 = u.pm * BM + wr * 64 + fr, col0 = u.pn * BM + wc * 32 + 4 * fq;
#pragma unroll
        for (int ai = 0; ai < 2; ++ai)
#pragma unroll
            for (int m = 0; m < 4; ++m) { const size_t off = (size_t)(row0 + ai * HALF + m * 16) * ldc + col0;
#pragma unroll
                for (int bj = 0; bj < 2; ++bj)
#pragma unroll
                    for (int n = 0; n < 2; ++n) { const f32x4 b = *(const f32x4*)(base + off + bj * HALF + n * 16); *(f32x4*)(Y + off + bj * HALF + n * 16) = b * alpha + acc[ai][bj][m][n]; } }
    }
};
struct EpiSwiGLU {
    static constexpr bool PERM = true, AFTER_DRAIN = false;
    bf16* Hd; const LAS float* gatebuf;
    __device__ __forceinline__ void operator()(const f32x4 (&acc)[2][2][4][2], const Unit& u, int wr, int wc, int fr, int fq) const {
        const int r0 = wr * 64 + fr, col0 = u.pn * HALF + wc * 32 + 8 * fq;
#pragma unroll
        for (int ai = 0; ai < 2; ++ai)
#pragma unroll
            for (int m = 0; m < 4; ++m) { const int r = r0 + ai * HALF + m * 16; const float gt = gatebuf[u.ord * 256 + r];
                float o[8];
#pragma unroll
                for (int n = 0; n < 2; ++n)
#pragma unroll
                    for (int e = 0; e < 4; ++e) { const float g = acc[ai][0][m][n][e], up = acc[ai][1][m][n][e];
                        const float sg = g * __builtin_amdgcn_rcpf(1.0f + __builtin_amdgcn_exp2f(-g * LOG2E)); o[n * 4 + e] = sg * up * gt; }
                u32x4 w; w.x = cvt_pk_bf16(o[0], o[1]); w.y = cvt_pk_bf16(o[2], o[3]); w.z = cvt_pk_bf16(o[4], o[5]); w.w = cvt_pk_bf16(o[6], o[7]);
                *(u32x4*)(Hd + (size_t)(u.pm * BM + r) * DE + col0) = w; }
    }
};
struct EpiSoftmax {
    static constexpr bool PERM = true, AFTER_DRAIN = true;
    bf16* O; int ldc; float scale2;
    __device__ __forceinline__ void operator()(const f32x4 (&)[2][2][4][2], const Unit&, int, int, int, int) const {}
    __device__ __forceinline__ void fused(f32x4 (&acc)[2][2][4][2], const Unit& u, int wr, int wc, int fr, int fq, lds_u8* lds, int wid, int lane) const {
        LAS float* X = (LAS float*)lds;
        LAS float* Z = (LAS float*)(lds + 4096);
        float mx[2][4];
#pragma unroll
        for (int ai = 0; ai < 2; ++ai)
#pragma unroll
            for (int m = 0; m < 4; ++m) { float v = -3.0e38f;
#pragma unroll
                for (int bj = 0; bj < 2; ++bj)
#pragma unroll
                    for (int n = 0; n < 2; ++n) { acc[ai][bj][m][n] = acc[ai][bj][m][n] * scale2; const f32x4 x = acc[ai][bj][m][n]; v = fmaxf(v, fmaxf(fmaxf(x[0], x[1]), fmaxf(x[2], x[3]))); }
                v = fmaxf(v, __shfl_xor(v, 16)); v = fmaxf(v, __shfl_xor(v, 32));
                if (fq == 0) X[(ai * HALF + wr * 64 + m * 16 + fr) * 4 + wc] = v; }
        asm volatile("s_waitcnt lgkmcnt(0)" ::: "memory"); __builtin_amdgcn_s_barrier(); asm volatile("" ::: "memory");
#pragma unroll
        for (int ai = 0; ai < 2; ++ai)
#pragma unroll
            for (int m = 0; m < 4; ++m) { const int r = ai * HALF + wr * 64 + m * 16 + fr; const f32x4 t = *(const LAS f32x4*)(X + r * 4);
                const float mm = fmaxf(fmaxf(t[0], t[1]), fmaxf(t[2], t[3])); mx[ai][m] = mm; float s = 0.f;
#pragma unroll
                for (int bj = 0; bj < 2; ++bj)
#pragma unroll
                    for (int n = 0; n < 2; ++n) { f32x4 x = acc[ai][bj][m][n];
#pragma unroll
                        for (int e = 0; e < 4; ++e) x[e] = __builtin_amdgcn_exp2f(x[e] - mm);
                        acc[ai][bj][m][n] = x; s += (x[0] + x[1]) + (x[2] + x[3]); }
                s += __shfl_xor(s, 16); s += __shfl_xor(s, 32);
                if (fq == 0) Z[r * 4 + wc] = s; }
        asm volatile("s_waitcnt lgkmcnt(0)" ::: "memory"); __builtin_amdgcn_s_barrier(); asm volatile("" ::: "memory");
        const int row0 = u.pm * BM + wr * 64 + fr, col0 = u.pn * BM + wc * 32 + 8 * fq;
#pragma unroll
        for (int ai = 0; ai < 2; ++ai)
#pragma unroll
            for (int m = 0; m < 4; ++m) { const int r = ai * HALF + wr * 64 + m * 16 + fr; const f32x4 t = *(const LAS f32x4*)(Z + r * 4);
                const float inv = 1.0f / ((t[0] + t[1]) + (t[2] + t[3]));
                bf16* rowp = O + (size_t)(row0 + ai * HALF + m * 16) * ldc + col0;
#pragma unroll
                for (int bj = 0; bj < 2; ++bj) { const f32x4 v0 = acc[ai][bj][m][0] * inv, v1 = acc[ai][bj][m][1] * inv;
                    u32x4 w; w.x = cvt_pk_bf16(v0[0], v0[1]); w.y = cvt_pk_bf16(v0[2], v0[3]); w.z = cvt_pk_bf16(v1[0], v1[1]); w.w = cvt_pk_bf16(v1[2], v1[3]);
                    *(u32x4*)(rowp + bj * HALF) = w; } }
        (void)mx; (void)wid; (void)lane;
    }
};

template <class Epi, class Prob, bool ALIGN_EPI>
__device__ __forceinline__ void gemm_phase(lds_u8* lds, const Prob& P, const Epi& E, const int tid) {
    const int wid = __builtin_amdgcn_readfirstlane(tid >> 6), lane = tid & 63, wr = wid >> 2, wc = wid & 3, fr = lane & 15, fq = lane >> 4;
    const int nt = P.K / BK;
    int Rr[2], Cc[2]; unsigned voffB[2];
#pragma unroll
    for (int i = 0; i < 2; ++i) { stage_rc(tid * 16 + i * 8192, Rr[i], Cc[i]); const int Rb = Epi::PERM ? ((Rr[i] & ~31) + perm32(Rr[i] & 31)) : Rr[i];
        voffB[i] = (unsigned)(Rb * P.ldb + Cc[i]) * 2u; }
    const size_t kstep = (size_t)(BK * 2);
    const size_t hstepB = (size_t)HALF * P.ldb * 2;
    const unsigned ldsw = (unsigned)wid * 1024u;
    const int aoff = lds_byte(wr * 64 + fr, fq * 8), boff = lds_byte(wc * 32 + fr, fq * 8);
#define PG8_SA(b, h) (((b) * 2 + (h)) * HTB)
#define PG8_SB(b, h) ((4 + (b) * 2 + (h)) * HTB)
#define PG8_STAGE(bufoff, gbase, voff) do { _Pragma("unroll") for (int _i = 0; _i < 2; ++_i) \
        __builtin_amdgcn_global_load_lds((const unsigned*)((const char*)(gbase) + (voff)[_i]), (LAS unsigned*)(lds + (bufoff) + ldsw + _i * 8192), 16, 0, 0); } while (0)
#define PG8_LDA(dst, b, h) do { _Pragma("unroll") for (int m = 0; m < 4; ++m) _Pragma("unroll") for (int k = 0; k < 2; ++k) dst[m][k] = *(const LAS bf16x8*)(lds + PG8_SA(b, h) + aoff + m * 2048 + k * 1024); } while (0)
#define PG8_LDB(dst, b, h) do { _Pragma("unroll") for (int n = 0; n < 2; ++n) _Pragma("unroll") for (int k = 0; k < 2; ++k) dst[n][k] = *(const LAS bf16x8*)(lds + PG8_SB(b, h) + boff + n * 2048 + k * 1024); } while (0)
#define PG8_MMA(ai, bj, At, Bt) do { __builtin_amdgcn_s_setprio(1); _Pragma("unroll") for (int m = 0; m < 4; ++m) _Pragma("unroll") for (int n = 0; n < 2; ++n) _Pragma("unroll") for (int k = 0; k < 2; ++k) \
        acc[ai][bj][m][n] = __builtin_amdgcn_mfma_f32_16x16x32_bf16(Bt[n][k], At[m][k], acc[ai][bj][m][n], 0, 0, 0); __builtin_amdgcn_s_setprio(0); } while (0)
#define PG8_WAIT_V(n) asm volatile("s_waitcnt vmcnt(" #n ")" ::: "memory")
#define PG8_WAIT_L(n) asm volatile("s_waitcnt lgkmcnt(" #n ")" ::: "memory")
#define PG8_BAR __builtin_amdgcn_s_barrier()
#define PG8_SCHED __builtin_amdgcn_sched_barrier(0)
    Unit cur, nxt; int ui = 0;
    if (!P.next(0, cur)) return;
    f32x4 acc[2][2][4][2];
#pragma unroll
    for (int a = 0; a < 2; ++a)
#pragma unroll
        for (int b = 0; b < 2; ++b)
#pragma unroll
            for (int m = 0; m < 4; ++m)
#pragma unroll
                for (int n = 0; n < 2; ++n) acc[a][b][m][n] = (f32x4){0.f, 0.f, 0.f, 0.f};
    bf16x8 At[4][2], B0[2][2], B1[2][2];
    unsigned vA[2][2], nvA[2][2];
    P.a_offs(cur, Rr, Cc, vA);
    const char* cA = P.a_base(cur); const char* cB = P.b_base(cur);
    PG8_STAGE(PG8_SB(0, 0), cB, voffB); PG8_STAGE(PG8_SB(0, 1), cB + hstepB, voffB); PG8_STAGE(PG8_SA(0, 0), cA, vA[0]); PG8_STAGE(PG8_SA(0, 1), cA, vA[1]);
    if (wr == 1) PG8_BAR;
    PG8_WAIT_V(2); PG8_BAR;
    PG8_STAGE(PG8_SB(1, 0), cB + kstep, voffB); PG8_STAGE(PG8_SA(1, 0), cA + kstep, vA[0]); PG8_STAGE(PG8_SB(1, 1), cB + hstepB + kstep, voffB);
    PG8_WAIT_V(6); PG8_BAR;
    for (;;) {
        const bool has_next = P.next(ui + 1, nxt);
        const char* nA = cA; const char* nB = cB;
#pragma unroll
        for (int h = 0; h < 2; ++h)
#pragma unroll
            for (int i = 0; i < 2; ++i) nvA[h][i] = vA[h][i];
        if (has_next) { nA = P.a_base(nxt); nB = P.b_base(nxt); P.a_offs(nxt, Rr, Cc, nvA); }
        for (int t = 0; t < nt; t += 2) {
            const bool last = (t == nt - 2);
            const char* a1 = cA + (size_t)(t + 1) * kstep;
            const char* a2 = last ? nA : cA + (size_t)(t + 2) * kstep; const char* b2 = last ? nB : cB + (size_t)(t + 2) * kstep;
            const char* a3 = a2 + kstep; const char* b3 = b2 + kstep;
            unsigned o2a[2], o2b[2];
#pragma unroll
            for (int i = 0; i < 2; ++i) { o2a[i] = last ? nvA[0][i] : vA[0][i]; o2b[i] = last ? nvA[1][i] : vA[1][i]; }
            PG8_LDB(B0, 0, 0); PG8_LDB(B1, 0, 1); PG8_SCHED; PG8_LDA(At, 0, 0); PG8_STAGE(PG8_SA(1, 1), a1, vA[1]);
            PG8_WAIT_V(8); PG8_WAIT_L(0); PG8_BAR; PG8_MMA(0, 0, At, B0); PG8_MMA(0, 1, At, B1); PG8_BAR; PG8_SCHED;
            PG8_LDA(At, 0, 1); PG8_STAGE(PG8_SB(0, 0), b2, voffB); PG8_STAGE(PG8_SB(0, 1), b2 + hstepB, voffB); PG8_STAGE(PG8_SA(0, 0), a2, o2a);
            PG8_WAIT_V(8); PG8_WAIT_L(0); PG8_BAR; PG8_MMA(1, 0, At, B0); PG8_MMA(1, 1, At, B1); PG8_BAR; PG8_SCHED;
            PG8_LDB(B0, 1, 0); PG8_LDB(B1, 1, 1); PG8_SCHED; PG8_LDA(At, 1, 0); PG8_STAGE(PG8_SA(0, 1), a2, o2b);
            PG8_WAIT_V(8); PG8_WAIT_L(0); PG8_BAR; PG8_MMA(0, 0, At, B0); PG8_MMA(0, 1, At, B1); PG8_BAR; PG8_SCHED;
            PG8_LDA(At, 1, 1); PG8_STAGE(PG8_SB(1, 0), b3, voffB); PG8_STAGE(PG8_SB(1, 1), b3 + hstepB, voffB); PG8_STAGE(PG8_SA(1, 0), a3, o2a);
            PG8_WAIT_V(8); PG8_WAIT_L(0); PG8_BAR; PG8_MMA(1, 0, At, B0); PG8_MMA(1, 1, At, B1); PG8_BAR; PG8_SCHED;
        }
        if constexpr (ALIGN_EPI) { if (wr == 0) PG8_BAR; }
        if constexpr (!Epi::AFTER_DRAIN) { E(acc, cur, wr, wc, fr, fq); }
        if (!has_next) break;
#pragma unroll
        for (int a = 0; a < 2; ++a)
#pragma unroll
            for (int b = 0; b < 2; ++b)
#pragma unroll
                for (int m = 0; m < 4; ++m)
#pragma unroll
                    for (int n = 0; n < 2; ++n) acc[a][b][m][n] = (f32x4){0.f, 0.f, 0.f, 0.f};
        cur = nxt; cA = nA; cB = nB; ++ui;
#pragma unroll
        for (int h = 0; h < 2; ++h)
#pragma unroll
            for (int i = 0; i < 2; ++i) vA[h][i] = nvA[h][i];
        if constexpr (ALIGN_EPI) { if (wr == 1) PG8_BAR; }
    }
    PG8_WAIT_V(0);
    if constexpr (!ALIGN_EPI) { if (wr == 0) PG8_BAR; }
    PG8_BAR;
    if constexpr (Epi::AFTER_DRAIN) { E.fused(acc, cur, wr, wc, fr, fq, lds, wid, lane); }
#undef PG8_SA
#undef PG8_SB
#undef PG8_STAGE
#undef PG8_LDA
#undef PG8_LDB
#undef PG8_MMA
#undef PG8_WAIT_V
#undef PG8_WAIT_L
#undef PG8_BAR
#undef PG8_SCHED
}
}

constexpr int NWAVES = 8;
struct Args {
    const float* in[25]; float* out; unsigned char* ws; int ph_lo, ph_hi;
};
static_assert(sizeof(Args) == 224, "Args layout (kernarg offsets in ka_ptr users)");
struct Frame {
    lds_u8* lds; volatile LAS unsigned* MISC; gu32* ctl;
    int tid, lane, wave, G, bid;
};
__device__ __forceinline__ void relaunder(Frame& F) { int t = threadIdx.x; asm volatile("" : "+v"(t)); F.tid = t; F.lane = t & 63; F.wave = __builtin_amdgcn_readfirstlane(t >> 6); int b = blockIdx.x; asm volatile("" : "+s"(b)); F.bid = b; }


typedef const unsigned char* cptr_t;
__device__ __forceinline__ cptr_t ka_ptr(int off) { const __attribute__((address_space(4))) unsigned char* p = (const __attribute__((address_space(4))) unsigned char*)__builtin_amdgcn_kernarg_segment_ptr(); asm volatile("" : "+s"(p)); return *(const __attribute__((address_space(4))) cptr_t*)(p + off); }
#define INP(i) ((const float*)ka_ptr(8 * (i)))
#define OUTP ((float*)ka_ptr(200))
#define WSP ((unsigned char*)ka_ptr(208))

struct Row { f32x4 v[8]; };
__device__ __forceinline__ void row_load_f32(Row& r, const float* p, int lane) {
#pragma unroll
    for (int j = 0; j < 4; ++j) { const f32x4* q = (const f32x4*)(p + 512 * j + 8 * lane); r.v[2 * j] = q[0]; r.v[2 * j + 1] = q[1]; }
}
__device__ __forceinline__ void row_store_f32(const Row& r, float* p, int lane) {
#pragma unroll
    for (int j = 0; j < 4; ++j) { f32x4* q = (f32x4*)(p + 512 * j + 8 * lane); q[0] = r.v[2 * j]; q[1] = r.v[2 * j + 1]; }
}
__device__ __forceinline__ void row_store_bf16(const Row& r, bf16* p, int lane) {
#pragma unroll
    for (int j = 0; j < 4; ++j) { const f32x4 a = r.v[2 * j], b = r.v[2 * j + 1]; u32x4 w; w.x = cvt_pk_bf16(a[0], a[1]); w.y = cvt_pk_bf16(a[2], a[3]); w.z = cvt_pk_bf16(b[0], b[1]); w.w = cvt_pk_bf16(b[2], b[3]);
        *(u32x4*)(p + 512 * j + 8 * lane) = w; }
}
__device__ __forceinline__ void row_add_bf16(Row& r, const bf16* p, int lane) {
#pragma unroll
    for (int j = 0; j < 4; ++j) { const u32x4 w = *(const u32x4*)(p + 512 * j + 8 * lane);
        r.v[2 * j] += (f32x4){bf_lo(w.x), bf_hi(w.x), bf_lo(w.y), bf_hi(w.y)}; r.v[2 * j + 1] += (f32x4){bf_lo(w.z), bf_hi(w.z), bf_lo(w.w), bf_hi(w.w)}; }
}
__device__ __forceinline__ void row_layernorm(Row& r, const Row& g, const Row& b) {
    float s = 0.f;
#pragma unroll
    for (int i = 0; i < 8; ++i) s += (r.v[i][0] + r.v[i][1]) + (r.v[i][2] + r.v[i][3]);
    const float mean = wave_sum(s) * (1.0f / D); float s2 = 0.f;
#pragma unroll
    for (int i = 0; i < 8; ++i) { r.v[i] = r.v[i] - mean; s2 += (r.v[i][0] * r.v[i][0] + r.v[i][1] * r.v[i][1]) + (r.v[i][2] * r.v[i][2] + r.v[i][3] * r.v[i][3]); }
    const float rstd = 1.0f / sqrtf(wave_sum(s2) * (1.0f / D) + LN_EPS);
#pragma unroll
    for (int i = 0; i < 8; ++i) r.v[i] = r.v[i] * rstd * g.v[i] + b.v[i];
}

__device__ __forceinline__ void tr_item(const float* W, int N, int k0, int n0, bf16* WT, size_t orow0, int K, LAS float* scr, int lane) {
    f32x4 v[16];
#pragma unroll
    for (int i = 0; i < 16; ++i) v[i] = *(const f32x4*)(W + (size_t)(k0 + 4 * i + (lane >> 4)) * N + n0 + 4 * (lane & 15));
#pragma unroll
    for (int i = 0; i < 16; ++i) { LAS float* s = scr + (4 * i + (lane >> 4)) * 65 + 4 * (lane & 15); s[0] = v[i][0]; s[1] = v[i][1]; s[2] = v[i][2]; s[3] = v[i][3]; }
    LDS_WAIT(); asm volatile("" ::: "memory");
    const int c = lane >> 3;
#pragma unroll
    for (int p = 0; p < 8; ++p) { const int n = 8 * p + (lane & 7); const LAS float* s = scr + (8 * c) * 65 + n;
        u32x4 o; o.x = cvt_pk_bf16(s[0 * 65], s[1 * 65]); o.y = cvt_pk_bf16(s[2 * 65], s[3 * 65]); o.z = cvt_pk_bf16(s[4 * 65], s[5 * 65]); o.w = cvt_pk_bf16(s[6 * 65], s[7 * 65]);
        *(u32x4*)(WT + (orow0 + n) * (size_t)K + k0 + 8 * c) = o; }
    LDS_WAIT(); asm volatile("" ::: "memory");
}
template <bool GU> __device__ __forceinline__ void tr_matrix_item(const float* W, int K, int N, bf16* WT, size_t orow_base, int item, LAS float* scr, int lane) {
    const int nblk = N / 64, kb = item / nblk, nb = item % nblk, n0 = nb * 64;
    const size_t orow0 = orow_base + (GU ? (size_t)((n0 >> 7) * 256 + (n0 & 127)) : (size_t)n0);
    tr_item(W, N, kb * 64, n0, WT, orow0, K, scr, lane);
}

constexpr int ATT_ROWB = 160;
constexpr int ATT_TILE = 272 * ATT_ROWB;
typedef short v4i16_t __attribute__((ext_vector_type(4)));
__device__ __forceinline__ s16x4 vtr(const lds_u8* p) { return __builtin_bit_cast(s16x4, __builtin_amdgcn_ds_read_tr16_b64_v4i16((LAS v4i16_t*)p)); }
__device__ __forceinline__ void attn_phase(Frame& F, const bf16* proj, const float* sinks, bf16* oA, bf16* oB, float* lseB) {
    lds_u8* Kt = F.lds; lds_u8* Vt = F.lds + ATT_TILE;
    const int tid = F.tid, wid = F.wave, lane = F.lane, fr = lane & 15, fq = lane >> 4;
    for (int i = tid; i < 2 * 640; i += NWAVES * 64) { lds_u8* base = (i >= 640) ? Vt : Kt; *(LAS unsigned*)(base + 256 * ATT_ROWB + (i % 640) * 4) = 0u; }
    __syncthreads();
    for (int u = F.bid; u < 8192; u += F.G) {
        const int kind = u >> 11, rem = u & 2047, b = rem >> 9, h = (rem >> 5) & 15, j32 = rem & 31;
        const int dsh = (kind <= 1) ? 0 : (kind == 2 ? 2 : 4), d = 1 << dsh, nbpr = 32 >> dsh, r = j32 / nbpr, nb = j32 % nbpr;
        const int qcol = (kind == 0) ? h * 64 : 1280 + h * 64, kcol = (kind == 0) ? 1024 + (h >> 3) * 64 : 2304 + h * 64, vcol = (kind == 0) ? 1152 + (h >> 3) * 64 : 3328 + h * 64;
        const int max_off = (kind == 0) ? 127 : 128;
        const float slope2 = __builtin_amdgcn_exp2f(-0.5f * (float)(h + 1)) * (float)d * LOG2E;
        const float sink2 = (kind == 0) ? sinks[h] * LOG2E : -__builtin_inff();
        const size_t tok0 = (size_t)b * SEQ + r;
#pragma unroll
        for (int i = 0; i < 4; ++i) { const int row = (tid >> 3) + 64 * i, c = tid & 7; int t = (nb - 1) * 128 + row; t = t < 0 ? 0 : t;
            const bf16* src = proj + (tok0 + (size_t)d * t) * INW + c * 8;
            const u32x4 kv = *(const u32x4*)(src + kcol), vv = *(const u32x4*)(src + vcol);
            *(LAS u32x4*)(Kt + row * ATT_ROWB + c * 16) = kv; *(LAS u32x4*)(Vt + row * ATT_ROWB + c * 16) = vv; }
        const int tq = nb * 128 + wid * 16 + fr; const size_t tokq = tok0 + (size_t)d * tq;
        const bf16x8 q0 = *(const bf16x8*)(proj + tokq * INW + qcol + 8 * fq), q1 = *(const bf16x8*)(proj + tokq * INW + qcol + 32 + 8 * fq);
        __syncthreads();
        f32x4 s[9];
#pragma unroll
        for (int j = 0; j < 9; ++j) { const lds_u8* kp = Kt + (16 * (wid + j) + fr) * ATT_ROWB + fq * 16;
            const bf16x8 a0 = *(const LAS bf16x8*)kp, a1 = *(const LAS bf16x8*)(kp + 64);
            f32x4 z = (f32x4){0.f, 0.f, 0.f, 0.f}; z = __builtin_amdgcn_mfma_f32_16x16x32_bf16(a0, q0, z, 0, 0, 0); s[j] = __builtin_amdgcn_mfma_f32_16x16x32_bf16(a1, q1, z, 0, 0, 0); }
        float mx = -__builtin_inff();
#pragma unroll
        for (int j = 0; j < 9; ++j)
#pragma unroll
            for (int e = 0; e < 4; ++e) { const int delta = 128 + fr - 16 * j - 4 * fq - e; const int tk = (nb - 1) * 128 + 16 * (wid + j) + 4 * fq + e;
                const bool valid = (delta >= 0) && (delta <= max_off) && (tk >= 0);
                const float v = valid ? (s[j][e] * (0.125f * LOG2E) - slope2 * (float)delta) : -__builtin_inff(); s[j][e] = v; mx = fmaxf(mx, v); }
        mx = fmaxf(mx, __shfl_xor(mx, 16)); mx = fmaxf(mx, __shfl_xor(mx, 32)); mx = fmaxf(mx, sink2);
        float sum = 0.f;
#pragma unroll
        for (int j = 0; j < 9; ++j)
#pragma unroll
            for (int e = 0; e < 4; ++e) { const float p = __builtin_amdgcn_exp2f(s[j][e] - mx); s[j][e] = p; sum += p; }
        sum += __shfl_xor(sum, 16); sum += __shfl_xor(sum, 32); sum += __builtin_amdgcn_exp2f(sink2 - mx);
        bf16x8 pb[5];
#pragma unroll
        for (int ks = 0; ks < 5; ++ks) { u32x4 w; w.x = cvt_pk_bf16(s[2 * ks][0], s[2 * ks][1]); w.y = cvt_pk_bf16(s[2 * ks][2], s[2 * ks][3]);
            if (ks < 4) { w.z = cvt_pk_bf16(s[2 * ks + 1][0], s[2 * ks + 1][1]); w.w = cvt_pk_bf16(s[2 * ks + 1][2], s[2 * ks + 1][3]); } else { w.z = 0u; w.w = 0u; }
            pb[ks] = __builtin_bit_cast(bf16x8, w); }
        f32x4 o[4];
#pragma unroll
        for (int dt = 0; dt < 4; ++dt) { f32x4 z = (f32x4){0.f, 0.f, 0.f, 0.f};
#pragma unroll
            for (int ks = 0; ks < 5; ++ks) { const lds_u8* vp = Vt + (16 * (wid + 2 * ks) + 4 * fq + (fr >> 2)) * ATT_ROWB + (16 * dt + 4 * (fr & 3)) * 2;
                const s16x4 v0 = vtr(vp), v1 = vtr(vp + 16 * ATT_ROWB);
                const bf16x8 a = (bf16x8){v0[0], v0[1], v0[2], v0[3], v1[0], v1[1], v1[2], v1[3]};
                z = __builtin_amdgcn_mfma_f32_16x16x32_bf16(a, pb[ks], z, 0, 0, 0); }
            o[dt] = z; }
        const float inv = 1.0f / sum;
        bf16* orow = ((kind == 0) ? oA : oB + (size_t)(kind - 1) * M * 1024) + tokq * 1024 + h * 64 + 4 * fq;
#pragma unroll
        for (int dt = 0; dt < 4; ++dt) { u32x2 w; w.x = cvt_pk_bf16(o[dt][0] * inv, o[dt][1] * inv); w.y = cvt_pk_bf16(o[dt][2] * inv, o[dt][3] * inv); *(u32x2*)(orow + 16 * dt) = w; }
        if (kind > 0 && fq == 0) lseB[((size_t)(kind - 1) * M + tokq) * 16 + h] = mx + __builtin_amdgcn_logf(sum);
        __syncthreads();
    }
}

__device__ __forceinline__ void merge_phase(Frame& F, const bf16* oA, const bf16* oB, const float* lseB, const float* ga, const float* gb, bf16* mixed) {
    const int lane = F.lane, gw = F.bid * NWAVES + F.wave, NGW = F.G * NWAVES;
    f32x4 gA[4], gB[4];
#pragma unroll
    for (int jj = 0; jj < 2; ++jj) { gA[2 * jj] = *(const f32x4*)(ga + 512 * jj + 8 * lane); gA[2 * jj + 1] = *(const f32x4*)(ga + 512 * jj + 8 * lane + 4);
        gB[2 * jj] = *(const f32x4*)(gb + 512 * jj + 8 * lane); gB[2 * jj + 1] = *(const f32x4*)(gb + 512 * jj + 8 * lane + 4); }
    for (int t = gw; t < M; t += NGW) {
        f32x4 a[4], bb[4];
        float ssa = 0.f, ssb = 0.f;
#pragma unroll
        for (int jj = 0; jj < 2; ++jj) {
            const int e0 = 512 * jj + 8 * lane, hh = e0 >> 6;
            const u32x4 w = *(const u32x4*)(oA + (size_t)t * 1024 + e0);
            a[2 * jj] = (f32x4){bf_lo(w.x), bf_hi(w.x), bf_lo(w.y), bf_hi(w.y)}; a[2 * jj + 1] = (f32x4){bf_lo(w.z), bf_hi(w.z), bf_lo(w.w), bf_hi(w.w)};
            float l0 = lseB[((size_t)0 * M + t) * 16 + hh], l1 = lseB[((size_t)1 * M + t) * 16 + hh], l2 = lseB[((size_t)2 * M + t) * 16 + hh];
            const float lm = fmaxf(l0, fmaxf(l1, l2)); l0 = __builtin_amdgcn_exp2f(l0 - lm); l1 = __builtin_amdgcn_exp2f(l1 - lm); l2 = __builtin_amdgcn_exp2f(l2 - lm);
            const float li = 1.0f / (l0 + l1 + l2); l0 *= li; l1 *= li; l2 *= li;
            const u32x4 w0 = *(const u32x4*)(oB + ((size_t)0 * M + t) * 1024 + e0), w1 = *(const u32x4*)(oB + ((size_t)1 * M + t) * 1024 + e0), w2 = *(const u32x4*)(oB + ((size_t)2 * M + t) * 1024 + e0);
            bb[2 * jj] = (f32x4){bf_lo(w0.x), bf_hi(w0.x), bf_lo(w0.y), bf_hi(w0.y)} * l0 + (f32x4){bf_lo(w1.x), bf_hi(w1.x), bf_lo(w1.y), bf_hi(w1.y)} * l1 + (f32x4){bf_lo(w2.x), bf_hi(w2.x), bf_lo(w2.y), bf_hi(w2.y)} * l2;
            bb[2 * jj + 1] = (f32x4){bf_lo(w0.z), bf_hi(w0.z), bf_lo(w0.w), bf_hi(w0.w)} * l0 + (f32x4){bf_lo(w1.z), bf_hi(w1.z), bf_lo(w1.w), bf_hi(w1.w)} * l1 + (f32x4){bf_lo(w2.z), bf_hi(w2.z), bf_lo(w2.w), bf_hi(w2.w)} * l2;
        }
#pragma unroll
        for (int i = 0; i < 4; ++i) { ssa += (a[i][0] * a[i][0] + a[i][1] * a[i][1]) + (a[i][2] * a[i][2] + a[i][3] * a[i][3]); ssb += (bb[i][0] * bb[i][0] + bb[i][1] * bb[i][1]) + (bb[i][2] * bb[i][2] + bb[i][3] * bb[i][3]); }
        const float ra = 1.0f / sqrtf(wave_sum(ssa) * (1.0f / 1024.0f) + RMS_EPS), rb = 1.0f / sqrtf(wave_sum(ssb) * (1.0f / 1024.0f) + RMS_EPS);
#pragma unroll
        for (int jj = 0; jj < 2; ++jj) { const int e0 = 512 * jj + 8 * lane;
            const f32x4 x0 = a[2 * jj] * ra * gA[2 * jj], x1 = a[2 * jj + 1] * ra * gA[2 * jj + 1], y0 = bb[2 * jj] * rb * gB[2 * jj], y1 = bb[2 * jj + 1] * rb * gB[2 * jj + 1];
            u32x4 w; w.x = cvt_pk_bf16(x0[0], x0[1]); w.y = cvt_pk_bf16(x0[2], x0[3]); w.z = cvt_pk_bf16(x1[0], x1[1]); w.w = cvt_pk_bf16(x1[2], x1[3]);
            *(u32x4*)(mixed + (size_t)t * D + e0) = w;
            w.x = cvt_pk_bf16(y0[0], y0[1]); w.y = cvt_pk_bf16(y0[2], y0[3]); w.z = cvt_pk_bf16(y1[0], y1[1]); w.w = cvt_pk_bf16(y1[2], y1[3]);
            *(u32x4*)(mixed + (size_t)t * D + 1024 + e0) = w; }
    }
}

__device__ __forceinline__ void ln_phase(Frame& F, const float* y, const float* g, const float* b, float* hout, bf16* hb) {
    const int lane = F.lane, gw = F.bid * NWAVES + F.wave, NGW = F.G * NWAVES;
    Row rg, rb; row_load_f32(rg, g, lane); row_load_f32(rb, b, lane);
    for (int t = gw; t < M; t += NGW) { Row r; row_load_f32(r, y + (size_t)t * D, lane); row_layernorm(r, rg, rb); row_store_f32(r, hout + (size_t)t * D, lane); if (hb) row_store_bf16(r, hb + (size_t)t * D, lane); }
}

__device__ __forceinline__ void router_phase(Frame& F, const float* h, const float* wr_, const float* rbias, gu32* cnt, int* tok_e, int* tok_slot, float* tok_gate, int* row_tok, float* row_gate) {
    const int tid = F.tid, wid = F.wave, lane = F.lane, fr = lane & 15, fq = lane >> 4;
    LAS float* sc = (LAS float*)F.lds;
    LAS int* lcnt = (LAS int*)(F.lds + 17408);
    LAS int* gbase = (LAS int*)(F.lds + 17408 + 256);
    LAS int* ti_e = (LAS int*)(F.lds + 18432);
    LAS int* ti_ls = (LAS int*)(F.lds + 18432 + 2048);
    LAS float* ti_g = (LAS float*)(F.lds + 18432 + 4096);
    for (int i = F.bid * NWAVES * 64 + tid; i < NROWS; i += F.G * NWAVES * 64) { const bool sh = i >= RB_SHARED0 * 256; row_tok[i] = sh ? i - RB_SHARED0 * 256 : 0; row_gate[i] = sh ? 1.0f : 0.0f; }
    for (int grp = F.bid; grp < M / 64; grp += F.G) {
        if (tid < 64) lcnt[tid] = 0;
        {
            constexpr int RDEPTH = 4, NIT = 64;
            f32x4 acc[4];
#pragma unroll
            for (int n = 0; n < 4; ++n) acc[n] = (f32x4){0.f, 0.f, 0.f, 0.f};
            const int kh = wid >> 2, ws4 = wid & 3;
            const float* xrow = h + (size_t)(grp * 64 + ws4 * 16 + fr) * D + kh * 1024 + 4 * fq;
            const float* wb = wr_ + (size_t)(kh * 1024 + 4 * fq) * NE + 4 * fr;
            f32x4 ra[RDEPTH], rb[RDEPTH][4];
#pragma unroll
            for (int i = 0; i < RDEPTH; ++i) { ra[i] = *(const f32x4*)(xrow + 16 * i);
#pragma unroll
                for (int s = 0; s < 4; ++s) rb[i][s] = *(const f32x4*)(wb + (size_t)(16 * i + s) * NE); }
#pragma unroll 1
            for (int it = 0; it < NIT; it += RDEPTH) {
#pragma unroll
                for (int u = 0; u < RDEPTH; ++u) {
                    const f32x4 a = ra[u]; f32x4 bq[4];
#pragma unroll
                    for (int s = 0; s < 4; ++s) bq[s] = rb[u][s];
                    if (it + RDEPTH < NIT) { const int nx = it + RDEPTH + u; ra[u] = *(const f32x4*)(xrow + 16 * nx);
#pragma unroll
                        for (int s = 0; s < 4; ++s) rb[u][s] = *(const f32x4*)(wb + (size_t)(16 * nx + s) * NE); }
#pragma unroll
                    for (int s = 0; s < 4; ++s)
#pragma unroll
                        for (int n = 0; n < 4; ++n) acc[n] = __builtin_amdgcn_mfma_f32_16x16x4f32(a[s], bq[s][n], acc[n], 0, 0, 0);
                }
            }
            if (kh == 1) {
#pragma unroll
                for (int n = 0; n < 4; ++n)
#pragma unroll
                    for (int e = 0; e < 4; ++e) sc[(ws4 * 16 + 4 * fq + e) * 65 + 4 * fr + n] = acc[n][e];
            }
            __syncthreads();
            if (kh == 0) {
#pragma unroll
                for (int n = 0; n < 4; ++n)
#pragma unroll
                    for (int e = 0; e < 4; ++e) sc[(ws4 * 16 + 4 * fq + e) * 65 + 4 * fr + n] += acc[n][e];
            }
        }
        __syncthreads();
        const float bias = rbias[lane];
        for (int ti = 0; ti < 8; ++ti) {
            const int tl = wid * 8 + ti;
            const float logit = sc[tl * 65 + lane];
            const float score = 1.0f / (1.0f + __expf(-logit));
            const float selv = score + bias;
            float m1 = selv;
#pragma unroll
            for (int o = 1; o < 8; o <<= 1) m1 = fmaxf(m1, __shfl_xor(m1, o));
            int i1 = (selv == m1) ? lane : 64;
#pragma unroll
            for (int o = 1; o < 8; o <<= 1) { const int x = __shfl_xor(i1, o); i1 = x < i1 ? x : i1; }
            float m2 = (lane == i1) ? -__builtin_inff() : selv;
#pragma unroll
            for (int o = 1; o < 8; o <<= 1) m2 = fmaxf(m2, __shfl_xor(m2, o));
            const float gs = m1 + m2; const int gi = lane >> 3;
            int rg = 0;
#pragma unroll
            for (int j = 0; j < 8; ++j) { const float og = __shfl(gs, 8 * j); rg += ((og > gs) || (og == gs && j < gi)) ? 1 : 0; }
            const bool gsel = rg < 4;
            const float mv = gsel ? selv : -__builtin_inff();
            int rk = 0;
#pragma unroll 4
            for (int j = 0; j < 64; ++j) { const float ov = __shfl(mv, j); rk += ((ov > mv) || (ov == mv && j < lane)) ? 1 : 0; }
            const bool chosen = gsel && (rk < TOPK);
            const float ssum = wave_sum(chosen ? score : 0.0f);
            if (chosen) { const int ls = __hip_atomic_fetch_add(lcnt + lane, 1, __ATOMIC_RELAXED, __HIP_MEMORY_SCOPE_WORKGROUP); ti_e[tl * 8 + rk] = lane; ti_ls[tl * 8 + rk] = ls; ti_g[tl * 8 + rk] = score / ssum * 2.5f; }
        }
        __syncthreads();
        if (tid < 64) gbase[tid] = (int)__hip_atomic_fetch_add((unsigned*)(cnt + tid), (unsigned)lcnt[tid], RLX_AGENT);
        __syncthreads();
        { const int e = ti_e[tid]; const size_t gi = (size_t)grp * 512 + tid; tok_e[gi] = e; tok_slot[gi] = gbase[e] + ti_ls[tid]; tok_gate[gi] = ti_g[tid]; }
        __syncthreads();
    }
}

__device__ __forceinline__ void scatter_phase(Frame& F, const gu32* cnt, const int* tok_e, const int* tok_slot, const float* tok_gate, int* tok_pos, int* row_tok, float* row_gate, int* meta) {
    LAS int* pstart = (LAS int*)F.lds;
    if (F.tid == 0) { int acc = 0; for (int e = 0; e < NE; ++e) { pstart[e] = acc; const int c = (int)__hip_atomic_load(cnt + e, RLX_AGENT); acc += (c + 255) >> 8; } pstart[NE] = acc; }
    __syncthreads();
    if (F.bid == 0) {
        if (F.tid == 0) meta[0] = pstart[NE];
        if (F.tid < NE) { for (int b = pstart[F.tid]; b < pstart[F.tid + 1]; ++b) meta[16 + b] = F.tid; }
    }
    for (int i = F.bid * NWAVES * 64 + F.tid; i < M * TOPK; i += F.G * NWAVES * 64) {
        const int e = tok_e[i], pos = pstart[e] * 256 + tok_slot[i];
        row_tok[pos] = i >> 3; row_gate[pos] = tok_gate[i]; tok_pos[i] = pos;
    }
}

__device__ __forceinline__ void combine_phase(Frame& F, const float* hres, const bf16* yrows, const int* tok_pos, const float* g, const float* b, float* hout, bf16* hb) {
    const int lane = F.lane, gw = F.bid * NWAVES + F.wave, NGW = F.G * NWAVES;
    Row rg, rb; row_load_f32(rg, g, lane); row_load_f32(rb, b, lane);
    for (int t = gw; t < M; t += NGW) {
        Row r; row_load_f32(r, hres + (size_t)t * D, lane);
#pragma unroll
        for (int i = 0; i < 8; ++i) r.v[i] = r.v[i] * ALPHA;
        int pos[8];
#pragma unroll
        for (int k = 0; k < 8; ++k) pos[k] = tok_pos[(size_t)t * 8 + k];
#pragma unroll
        for (int k = 0; k < 8; ++k) row_add_bf16(r, yrows + (size_t)pos[k] * D, lane);
        row_add_bf16(r, yrows + (size_t)(RB_SHARED0 * 256 + t) * D, lane);
        row_layernorm(r, rg, rb);
        row_store_f32(r, hout + (size_t)t * D, lane); if (hb) row_store_bf16(r, hb + (size_t)t * D, lane);
    }
}

constexpr int NPH_LAYER = 16, NPH = 2 + DEPTH * NPH_LAYER;
constexpr size_t SZ_WIN = (size_t)D * INW, SZ_DD = (size_t)D * D, SZ_EXP = (size_t)D * DE;

__global__ void __launch_bounds__(NWAVES * 64, 2) mk_fwd(Args args) {
    extern __shared__ __attribute__((aligned(16))) unsigned char lds_raw[];
    Frame F;
    F.lds = (lds_u8*)lds_raw; F.MISC = (volatile LAS unsigned*)(F.lds + MISC_OFF);
    F.tid = threadIdx.x; F.lane = F.tid & 63; F.wave = __builtin_amdgcn_readfirstlane(F.tid >> 6); F.G = gridDim.x; F.bid = blockIdx.x;
    F.ctl = (gu32*)(WSP + WS_CTL);
    if (F.tid < 64) F.MISC[F.tid] = 0u;
    __syncthreads();
    const int lo = args.ph_lo, hi = args.ph_hi;
    const bool use_bar = (hi - lo) > 1;
    XcdBarrier bar; bar.bar = (unsigned*)(F.ctl + CW_BAR); bar.x = 0; bar.st = nullptr;
    if (use_bar) bar = xcd_barrier_post((unsigned*)(F.ctl + CW_BAR), F.MISC + 8);
#define IN(k) (lo <= (k) && (k) < hi)
#ifndef MK_BAR_REP
#define MK_BAR_REP 1
#endif
#define SEAM(k) do { if (IN(k) && IN((k) + 1)) { for (int br_ = 0; br_ < MK_BAR_REP; ++br_) xcd_barrier(bar); } } while (0)

#define xin ((const float*)INP(0))
#define memb ((bf16*)(WSP + WS_MEMB))
#define Kc ((bf16*)(WSP + WS_KC))
#define VT ((bf16*)(WSP + WS_VT))
#define WinT ((bf16*)(WSP + WS_WIN))
#define WoutT ((bf16*)(WSP + WS_WOUT))
#define WqT ((bf16*)(WSP + WS_WQ))
#define WoT ((bf16*)(WSP + WS_WO))
#define WguT ((bf16*)(WSP + WS_WGU))
#define WdT ((bf16*)(WSP + WS_WD))
#define hbuf ((float*)(WSP + WS_H))
#define hb ((bf16*)(WSP + WS_HB))
#define ybuf ((float*)(WSP + WS_Y))
#define proj ((bf16*)(WSP + WS_PROJ))
#define oA ((bf16*)(WSP + WS_OA))
#define oB ((bf16*)(WSP + WS_OB))
#define lseB ((float*)(WSP + WS_LSE))
#define mixed ((bf16*)(WSP + WS_MIXED))
#define qb ((bf16*)(WSP + WS_Q))
#define Pb ((bf16*)(WSP + WS_P))
#define ob ((bf16*)(WSP + WS_O))
#define WkT ((bf16*)(WSP + WS_WKT))
#define WvT ((bf16*)(WSP + WS_WVT))
#define hid ((bf16*)(WSP + WS_HID))
#define yrows ((bf16*)(WSP + WS_YROWS))
#define meta ((int*)(WSP + WS_META))
#define tok_e ((int*)(WSP + WS_TOKE))
#define tok_slot ((int*)(WSP + WS_TOKSLOT))
#define tok_gate ((float*)(WSP + WS_TOKGATE))
#define tok_pos ((int*)(WSP + WS_TOKPOS))
#define row_tok ((int*)(WSP + WS_ROWTOK))
#define row_gate ((float*)(WSP + WS_ROWGATE))

    if (KIND_EN(0) && IN(0)) for (int rep = 0; rep < NREP(0); ++rep) { relaunder(F);
        const int gw = F.bid * NWAVES + F.wave, NGW = F.G * NWAVES; LAS float* scr = (LAS float*)(F.lds + F.wave * 16640);
        { const float* xp = xin; bf16* hbp = hb;
        for (size_t i = (size_t)F.bid * NWAVES * 64 + F.tid; i < (size_t)M * D / 8; i += (size_t)F.G * NWAVES * 64) {
            const f32x4 a = *(const f32x4*)(xp + i * 8), b = *(const f32x4*)(xp + i * 8 + 4);
            u32x4 w; w.x = cvt_pk_bf16(a[0], a[1]); w.y = cvt_pk_bf16(a[2], a[3]); w.z = cvt_pk_bf16(b[0], b[1]); w.w = cvt_pk_bf16(b[2], b[3]); *(u32x4*)(hbp + i * 8) = w; } }
        { const float* mem = INP(1); bf16* mb = memb;
        for (size_t i = (size_t)F.bid * NWAVES * 64 + F.tid; i < (size_t)NBATCH * 256 * D / 8; i += (size_t)F.G * NWAVES * 64) {
            const f32x4 a = *(const f32x4*)(mem + i * 8), b = *(const f32x4*)(mem + i * 8 + 4);
            u32x4 w; w.x = cvt_pk_bf16(a[0], a[1]); w.y = cvt_pk_bf16(a[2], a[3]); w.z = cvt_pk_bf16(b[0], b[1]); w.w = cvt_pk_bf16(b[2], b[3]); *(u32x4*)(mb + i * 8) = w; } }
        { const float* wk = INP(10); const float* wv = INP(11); bf16* wkt = WkT; bf16* wvt = WvT;
        for (int it = gw; it < 4096; it += NGW) { const int mat = it >> 10, sub = it & 1023, l = mat & 1;
            const float* W = (mat < 2 ? wk : wv) + (size_t)l * SZ_DD;
            tr_matrix_item<false>(W, D, D, mat < 2 ? wkt : wvt, (size_t)l * D, sub, scr, F.lane); } }
    }
    SEAM(0);
    if (KIND_EN(1) && IN(1)) for (int rep = 0; rep < NREP(1); ++rep) { relaunder(F);
        { pg8::ProbStatic P{(const char*)memb, (const char*)WkT, D, D, D, (size_t)256 * D * 2, 0, 0, (size_t)256 * D * 2, 0, 1, {}}; P.S.init(4, 16, F.G, F.bid);
          pg8::EpiBf16 E{Kc, 2 * D, 1.0f}; pg8::gemm_phase<pg8::EpiBf16, pg8::ProbStatic, false>(F.lds, P, E, F.tid); }
        { pg8::ProbStatic P{(const char*)WvT, (const char*)memb, D, D, D, (size_t)256 * D * 2, 0, 0, (size_t)256 * D * 2, 0, 1, {}}; P.S.init(16, 4, F.G, (F.bid + F.G / 2) % F.G);
          pg8::EpiBf16 E{VT, 1024, 1.0f}; pg8::gemm_phase<pg8::EpiBf16, pg8::ProbStatic, false>(F.lds, P, E, F.tid); }
    }
    SEAM(1);

    for (int l = 0; l < DEPTH; ++l) {
        const int pb = 2 + NPH_LAYER * l;
        const float* hres = (l == 0) ? xin : hbuf;
        if (KIND_EN(2) && IN(pb + 0)) for (int rep = 0; rep < NREP(2); ++rep) { relaunder(F);
            const int gw = F.bid * NWAVES + F.wave, NGW = F.G * NWAVES; LAS float* scr = (LAS float*)(F.lds + F.wave * 16640);
            const float* w_in = INP(2) + (size_t)l * SZ_WIN; const float* w_out = INP(6) + (size_t)l * SZ_DD;
            const float* wq = INP(9) + (size_t)l * SZ_DD; const float* wo = INP(12) + (size_t)l * SZ_DD;
            const float* wg = INP(17) + (size_t)l * NE * SZ_EXP; const float* wu = INP(18) + (size_t)l * NE * SZ_EXP; const float* wd = INP(19) + (size_t)l * NE * SZ_EXP;
            const float* wsg = INP(20) + (size_t)l * SZ_EXP; const float* wsu = INP(21) + (size_t)l * SZ_EXP; const float* wsd = INP(22) + (size_t)l * SZ_EXP;
            bf16* pWin = WinT; bf16* pWout = WoutT; bf16* pWq = WqT; bf16* pWo = WoT; bf16* pWgu = WguT; bf16* pWd = WdT;
            constexpr int I_IN = 32 * 68, I_DD = 1024, I_E = 256, NIT = I_IN + 3 * I_DD + 3 * 65 * I_E;
            for (int it = gw; it < NIT; it += NGW) {
                int r = it;
                if (r < I_IN) { tr_matrix_item<false>(w_in, D, INW, pWin, 0, r, scr, F.lane); continue; } r -= I_IN;
                if (r < I_DD) { tr_matrix_item<false>(w_out, D, D, pWout, 0, r, scr, F.lane); continue; } r -= I_DD;
                if (r < I_DD) { tr_matrix_item<false>(wq, D, D, pWq, 0, r, scr, F.lane); continue; } r -= I_DD;
                if (r < I_DD) { tr_matrix_item<false>(wo, D, D, pWo, 0, r, scr, F.lane); continue; } r -= I_DD;
                if (r < 65 * I_E) { const int e = r >> 8; tr_matrix_item<true>(e < NE ? wg + (size_t)e * SZ_EXP : wsg, D, DE, pWgu + (size_t)e * 1024 * D, 0, r & 255, scr, F.lane); continue; } r -= 65 * I_E;
                if (r < 65 * I_E) { const int e = r >> 8; tr_matrix_item<true>(e < NE ? wu + (size_t)e * SZ_EXP : wsu, D, DE, pWgu + (size_t)e * 1024 * D, 128, r & 255, scr, F.lane); continue; } r -= 65 * I_E;
                { const int e = r >> 8; tr_matrix_item<false>(e < NE ? wd + (size_t)e * SZ_EXP : wsd, DE, D, pWd + (size_t)e * D * DE, 0, r & 255, scr, F.lane); }
            }
        }
        SEAM(pb + 0);
        if (KIND_EN(3) && IN(pb + 1)) for (int rep = 0; rep < NREP(3); ++rep) { relaunder(F);
            pg8::ProbStatic P{(const char*)hb, (const char*)WinT, D, D, D, (size_t)256 * D * 2, 0, 0, (size_t)256 * D * 2, 0, 1, {}}; P.S.init(M / 256, INW / 256, F.G, F.bid);
            pg8::EpiBf16 E{proj, INW, 1.0f}; pg8::gemm_phase<pg8::EpiBf16, pg8::ProbStatic, true>(F.lds, P, E, F.tid);
        }
        SEAM(pb + 1);
        if (KIND_EN(4) && IN(pb + 2)) for (int rep = 0; rep < NREP(4); ++rep) { relaunder(F); attn_phase(F, proj, INP(3) + l * 16, oA, oB, lseB); }
        SEAM(pb + 2);
        if (KIND_EN(5) && IN(pb + 3)) for (int rep = 0; rep < NREP(5); ++rep) { relaunder(F); merge_phase(F, oA, oB, lseB, INP(4) + l * 1024, INP(5) + l * 1024, mixed); }
        SEAM(pb + 3);
        if (KIND_EN(6) && IN(pb + 4)) for (int rep = 0; rep < NREP(6); ++rep) { relaunder(F);
            pg8::ProbStatic P{(const char*)mixed, (const char*)WoutT, D, D, D, (size_t)256 * D * 2, 0, 0, (size_t)256 * D * 2, 0, 1, {}}; P.S.init(M / 256, D / 256, F.G, F.bid);
            pg8::EpiResF32 E{hres, ybuf, D, ALPHA}; pg8::gemm_phase<pg8::EpiResF32, pg8::ProbStatic, true>(F.lds, P, E, F.tid);
        }
        SEAM(pb + 4);
        if (KIND_EN(7) && IN(pb + 5)) for (int rep = 0; rep < NREP(7); ++rep) { relaunder(F); ln_phase(F, ybuf, INP(7) + l * D, INP(8) + l * D, hbuf, hb); }
        SEAM(pb + 5);
        if (KIND_EN(8) && IN(pb + 6)) for (int rep = 0; rep < NREP(8); ++rep) { relaunder(F);
            pg8::ProbStatic P{(const char*)hb, (const char*)WqT, D, D, D, (size_t)256 * D * 2, 0, 0, (size_t)256 * D * 2, 0, 1, {}}; P.S.init(M / 256, D / 256, F.G, F.bid);
            pg8::EpiBf16 E{qb, D, 1.0f}; pg8::gemm_phase<pg8::EpiBf16, pg8::ProbStatic, true>(F.lds, P, E, F.tid);
        }
        SEAM(pb + 6);
        if (KIND_EN(9) && IN(pb + 7)) for (int rep = 0; rep < NREP(9); ++rep) { relaunder(F);
            pg8::ProbStatic P{(const char*)qb, (const char*)(Kc + (size_t)l * D), D, 2 * D, 512, (size_t)256 * D * 2, (size_t)512 * 2, 0, (size_t)512 * 2, (size_t)256 * 2 * D * 2, 16, {}}; P.S.init(M / 256, 4, F.G, F.bid);
            pg8::EpiSoftmax E{Pb, 1024, 0.044194173824159216f * LOG2E}; pg8::gemm_phase<pg8::EpiSoftmax, pg8::ProbStatic, false>(F.lds, P, E, F.tid);
        }
        SEAM(pb + 7);
        if (KIND_EN(10) && IN(pb + 8)) for (int rep = 0; rep < NREP(10); ++rep) { relaunder(F);
            pg8::ProbStatic P{(const char*)Pb, (const char*)(VT + (size_t)l * D * 1024), 1024, 1024, 256, (size_t)256 * 1024 * 2, (size_t)256 * 2, 1, (size_t)256 * 1024 * 2, (size_t)256 * 2, 16, {}}; P.S.init(M / 256, 8, F.G, F.bid);
            pg8::EpiBf16 E{ob, D, 1.0f}; pg8::gemm_phase<pg8::EpiBf16, pg8::ProbStatic, true>(F.lds, P, E, F.tid);
        }
        SEAM(pb + 8);
        if (KIND_EN(11) && IN(pb + 9)) for (int rep = 0; rep < NREP(11); ++rep) { relaunder(F);
            pg8::ProbStatic P{(const char*)ob, (const char*)WoT, D, D, D, (size_t)256 * D * 2, 0, 0, (size_t)256 * D * 2, 0, 1, {}}; P.S.init(M / 256, D / 256, F.G, F.bid);
            pg8::EpiResF32 E{hbuf, ybuf, D, ALPHA}; pg8::gemm_phase<pg8::EpiResF32, pg8::ProbStatic, true>(F.lds, P, E, F.tid);
        }
        SEAM(pb + 9);
        if (KIND_EN(12) && IN(pb + 10)) for (int rep = 0; rep < NREP(12); ++rep) { relaunder(F); ln_phase(F, ybuf, INP(13) + l * D, INP(14) + l * D, hbuf, hb); }
        SEAM(pb + 10);
        if (KIND_EN(13) && IN(pb + 11)) for (int rep = 0; rep < NREP(13); ++rep) { relaunder(F); router_phase(F, hbuf, INP(15) + (size_t)l * D * NE, INP(16) + l * NE, F.ctl + CW_CNT + ((rep + 1 < NREP(13)) ? 1024 : 0) + l * 64, tok_e, tok_slot, tok_gate, row_tok, row_gate); }
        SEAM(pb + 11);
        if (KIND_EN(14) && IN(pb + 12)) { relaunder(F); scatter_phase(F, F.ctl + CW_CNT + l * 64, tok_e, tok_slot, tok_gate, tok_pos, row_tok, row_gate, meta); }
        SEAM(pb + 12);
        if (KIND_EN(15) && IN(pb + 13)) for (int rep = 0; rep < NREP(15); ++rep) { relaunder(F);
            LAS int* blkexp = (LAS int*)(F.lds + BLKEXP_OFF); LAS int* tokbuf = (LAS int*)(F.lds + TOKBUF_OFF); LAS float* gatebuf = (LAS float*)(F.lds + GATEBUF_OFF);
            const int nblk = meta[0];
            for (int i = F.tid; i < 640; i += NWAVES * 64) blkexp[i] = (i < nblk) ? meta[16 + i] : NE;
            __syncthreads();
            const int ntot = (nblk + 64) * 4;
            pg8::ProbMoe<true> P{(const char*)hb, (const char*)WguT, D, D, D, 4, (size_t)1024 * D * 2, (size_t)256 * D * 2, blkexp, tokbuf, nblk, ntot, (ntot + 7) / 8, F.bid & 7, F.bid >> 3, F.G >> 3};
            for (int i = 0; i < MAXORD; ++i) { pg8::Unit u; if (!P.next(i, u)) break;
                if (F.tid < 256) tokbuf[i * 256 + F.tid] = row_tok[u.pm * 256 + F.tid]; else gatebuf[i * 256 + F.tid - 256] = row_gate[u.pm * 256 + F.tid - 256]; }
            __syncthreads();
            pg8::EpiSwiGLU E{hid, gatebuf}; pg8::gemm_phase<pg8::EpiSwiGLU, pg8::ProbMoe<true>, true>(F.lds, P, E, F.tid);
        }
        SEAM(pb + 13);
        if (KIND_EN(16) && IN(pb + 14)) for (int rep = 0; rep < NREP(16); ++rep) { relaunder(F);
            LAS int* blkexp = (LAS int*)(F.lds + BLKEXP_OFF);
            const int nblk = meta[0];
            for (int i = F.tid; i < 640; i += NWAVES * 64) blkexp[i] = (i < nblk) ? meta[16 + i] : NE;
            __syncthreads();
            const int ntot = (nblk + 64) * 8;
            pg8::ProbMoe<false> P{(const char*)hid, (const char*)WdT, DE, DE, DE, 8, (size_t)D * DE * 2, (size_t)256 * DE * 2, blkexp, nullptr, nblk, ntot, (ntot + 7) / 8, F.bid & 7, F.bid >> 3, F.G >> 3};
            pg8::EpiBf16 E{yrows, D, 1.0f}; pg8::gemm_phase<pg8::EpiBf16, pg8::ProbMoe<false>, true>(F.lds, P, E, F.tid);
        }
        SEAM(pb + 14);
        if (KIND_EN(17) && IN(pb + 15)) for (int rep = 0; rep < NREP(17); ++rep) { relaunder(F); combine_phase(F, hbuf, yrows, tok_pos, INP(23) + l * D, INP(24) + l * D, (rep + 1 < NREP(17)) ? ybuf : ((l == DEPTH - 1) ? OUTP : hbuf), (l == DEPTH - 1) ? nullptr : hb); }
        if (l + 1 < DEPTH) SEAM(pb + 15);
    }
    if (use_bar && hi == NPH) {
        if (__hip_atomic_load(F.ctl + CW_BAR + XB_TMO, RLX_AGENT) != 0u && F.tid == 0) { VM_WAIT(); OUTP[(size_t)F.bid * D] = __builtin_nanf(""); }
    }
#undef IN
#undef SEAM
}

extern "C" void kernel_launch(void* const* d_in, const int* in_sizes, int n_in, void* d_out, int out_size, void* d_ws, size_t ws_size, hipStream_t stream) {
    static int grid = 0;
    if (grid == 0) {
        if (n_in != 25 || in_sizes[0] != M * D || out_size != M * D || ws_size < WS_END) { fprintf(stderr, "kernel_launch: unexpected shapes (n_in %d, in0 %d, out %d, ws %zu, need %zu); nothing launched\n", n_in, n_in > 0 ? in_sizes[0] : -1, out_size, ws_size, (size_t)WS_END); grid = -1; return; }
        int dev = 0, cus = 0, per_cu = 0;
        if (hipGetDevice(&dev) != hipSuccess || hipDeviceGetAttribute(&cus, hipDeviceAttributeMultiprocessorCount, dev) != hipSuccess) { grid = -1; return; }
        if (hipFuncSetAttribute((const void*)mk_fwd, hipFuncAttributeMaxDynamicSharedMemorySize, LDS_BYTES) != hipSuccess) { fprintf(stderr, "kernel_launch: hipFuncSetAttribute failed\n"); grid = -1; return; }
        if (hipOccupancyMaxActiveBlocksPerMultiprocessor(&per_cu, (const void*)mk_fwd, NWAVES * 64, LDS_BYTES) != hipSuccess || per_cu < 1) fprintf(stderr, "kernel_launch: occupancy query reports %d\n", per_cu);
        (void)hipGetLastError();
        grid = cus;
        if (grid != 256) { fprintf(stderr, "kernel_launch: built for 256 CUs, device has %d; nothing launched\n", cus); grid = -1; return; }
    }
    if (grid < 0) return;
    if (hipMemsetAsync((char*)d_ws + WS_CTL, 0, CTL_ZERO_BYTES, stream) != hipSuccess) return;
    Args a{};
    for (int i = 0; i < 25; ++i) a.in[i] = (const float*)d_in[i];
    a.out = (float*)d_out; a.ws = (unsigned char*)d_ws;
#if MK_N_LAUNCHES == 1
    a.ph_lo = 0; a.ph_hi = NPH;
    hipLaunchKernelGGL(mk_fwd, dim3(grid), dim3(NWAVES * 64), LDS_BYTES, stream, a);
#else
    for (int p = 0; p < NPH; ++p) { a.ph_lo = p; a.ph_hi = p + 1; hipLaunchKernelGGL(mk_fwd, dim3(grid), dim3(NWAVES * 64), LDS_BYTES, stream, a); }
#endif
}
```

```cpp
#include <hip/hip_runtime.h>
#include <cstdio>
#include <cstdint>

#ifndef MK_N_LAUNCHES
#define MK_N_LAUNCHES 1
#endif
#ifndef MK_KINDS
#define MK_KINDS 0x3ffff
#endif
#define KIND_EN(k) (((MK_KINDS) >> (k)) & 1)
#ifndef MK_REP_MASK
#define MK_REP_MASK 0
#endif
#define NREP(k) (1 + (((MK_REP_MASK) >> (k)) & 1))

#define GAS __attribute__((address_space(1)))
#define LAS __attribute__((address_space(3)))
typedef unsigned short bf16;
typedef short bf16x8 __attribute__((ext_vector_type(8)));
typedef short s16x4 __attribute__((ext_vector_type(4)));
typedef float f32x4 __attribute__((ext_vector_type(4)));
typedef float f32x2 __attribute__((ext_vector_type(2)));
typedef unsigned u32x4 __attribute__((ext_vector_type(4)));
typedef unsigned u32x2 __attribute__((ext_vector_type(2)));
typedef int i32x8 __attribute__((ext_vector_type(8)));
typedef int i32x4 __attribute__((ext_vector_type(4)));
typedef LAS unsigned char lds_u8;
typedef GAS unsigned gu32;

constexpr int D = 2048, NBATCH = 4, SEQ = 4096, M = NBATCH * SEQ, DEPTH = 2;
constexpr int INW = 4352;
constexpr int NE = 64, TOPK = 8, DE = 512;
constexpr float ALPHA = 1.4142135623730951f;
constexpr float LN_EPS = 1e-5f, RMS_EPS = 1e-6f;
constexpr float LOG2E = 1.4426950408889634f;
constexpr int RB_SHARED0 = 576;
constexpr int NROWS = (RB_SHARED0 + 64) * 256;
constexpr int MAXORD = 12;

constexpr size_t MiB = 1u << 20;
constexpr size_t WS_CTL = 0, CTL_ZERO_BYTES = 1 * MiB;
constexpr size_t WS_META = 1 * MiB;
constexpr size_t WS_TOKE = 2 * MiB, WS_TOKSLOT = 2 * MiB + 512 * 1024, WS_TOKGATE = 3 * MiB, WS_TOKPOS = 3 * MiB + 512 * 1024;
constexpr size_t WS_ROWTOK = 4 * MiB, WS_ROWGATE = 5 * MiB;
constexpr size_t WS_MEMB = 6 * MiB, WS_KC = 10 * MiB, WS_VT = 18 * MiB;
constexpr size_t WS_WIN = 26 * MiB, WS_WOUT = 43 * MiB, WS_WQ = 51 * MiB, WS_WO = 59 * MiB, WS_WGU = 67 * MiB, WS_WD = 327 * MiB;
constexpr size_t WS_H = 457 * MiB, WS_HB = 585 * MiB, WS_Y = 649 * MiB, WS_R = 777 * MiB;
constexpr size_t WS_PROJ = WS_R, WS_OA = WS_R + 136 * MiB, WS_OB = WS_R + 168 * MiB, WS_LSE = WS_R + 264 * MiB, WS_MIXED = WS_R + 267 * MiB;
constexpr size_t WS_Q = WS_R + 331 * MiB, WS_P = WS_R + 395 * MiB, WS_O = WS_R + 427 * MiB;
constexpr size_t WS_WKT = WS_R, WS_WVT = WS_R + 16 * MiB;
constexpr size_t WS_HID = WS_R, WS_YROWS = WS_R + 160 * MiB;
constexpr size_t WS_END = WS_R + 800 * MiB;
constexpr int CW_TMO = 0, CW_CODE = 1;
constexpr int CW_BAR = 4096;
constexpr int CW_CNT = 16384;

constexpr int RING_BYTES = 131072;
constexpr int AUX_OFF = RING_BYTES;
constexpr int TOKBUF_OFF = AUX_OFF, GATEBUF_OFF = AUX_OFF + MAXORD * 1024, BLKEXP_OFF = GATEBUF_OFF + MAXORD * 1024;
constexpr int MISC_OFF = BLKEXP_OFF + 2560;
constexpr int LDS_BYTES = MISC_OFF + 256;
static_assert(LDS_BYTES <= 160 * 1024 && (MISC_OFF % 16) == 0, "LDS map");

#define RLX_AGENT __ATOMIC_RELAXED, __HIP_MEMORY_SCOPE_AGENT
#define LDS_WAIT() asm volatile("s_waitcnt lgkmcnt(0)" ::: "memory")
#define VM_WAIT() asm volatile("s_waitcnt vmcnt(0)" ::: "memory")
__device__ __forceinline__ unsigned cvt_pk_bf16(float lo, float hi) { unsigned r; asm volatile("v_cvt_pk_bf16_f32 %0, %1, %2" : "=v"(r) : "v"(lo), "v"(hi)); return r; }
__device__ __forceinline__ float bf_lo(unsigned w) { return __uint_as_float(w << 16); }
__device__ __forceinline__ float bf_hi(unsigned w) { return __uint_as_float(w & 0xffff0000u); }
__device__ __forceinline__ float wave_sum(float v) {
#pragma unroll
    for (int o = 1; o < 64; o <<= 1) v += __shfl_xor(v, o);
    return v;
}

#define XB_TMO      128
#define XB_XCNT(j)  (256  + 64 * (j))
#define XB_XSUB(j)  (1280 + 64 * (j))
#define XB_XGEN(j)  (2304 + 64 * (j))
#define XB_TOP      3328
#define XB_TOPGEN   3392
#define XCD_BAR_WORDS 3456
#define XB_SPIN_CAP (1u << 18)
__device__ __forceinline__ unsigned xb_ld(unsigned* p)              { return __hip_atomic_load(p, __ATOMIC_RELAXED, __HIP_MEMORY_SCOPE_AGENT); }
__device__ __forceinline__ unsigned xb_add(unsigned* p, unsigned v) { return __hip_atomic_fetch_add(p, v, __ATOMIC_RELAXED, __HIP_MEMORY_SCOPE_AGENT); }
__device__ __forceinline__ unsigned xb_xcc_id() { return (unsigned)__builtin_amdgcn_s_getreg((3 << 11) | 20) & 0xFu; }
#define XB_SPIN(cond, bar) do { unsigned _sp = 0; while (cond) { __builtin_amdgcn_s_sleep(1); \
    if ((++_sp & 255u) == 0u) { if (xb_ld(&(bar)[XB_TMO])) break; if (_sp > XB_SPIN_CAP) { atomicAdd(&(bar)[XB_TMO], 1u); break; } } } } while (0)
struct XcdBarrier { unsigned* bar; unsigned x; volatile LAS unsigned* st; };
__device__ __forceinline__ XcdBarrier xcd_barrier_post(unsigned* bar, volatile LAS unsigned* st) {
    XcdBarrier b; b.bar = bar; b.x = xb_xcc_id(); b.st = st;
    if (threadIdx.x == 0) (void)xb_add(&bar[XB_XCNT(b.x)], 1u);
    return b;
}
__device__ __forceinline__ void xcd_barrier_complete(unsigned* bar, unsigned x, unsigned& nloc, unsigned& nx) {
    const unsigned G = gridDim.x * gridDim.y * gridDim.z;
    unsigned sum, cnt, mine, sp = 0u;
    for (;;) {
        sum = 0u; cnt = 0u; mine = 0u;
#pragma unroll
        for (unsigned j = 0; j < 16; ++j) { const unsigned c = xb_ld(&bar[XB_XCNT(j)]); sum += c; cnt += (c > 0u) ? 1u : 0u; mine = (j == x) ? c : mine; }
        if (sum == G) break;
        __builtin_amdgcn_s_sleep(1);
        if ((++sp & 255u) == 0u) { if (xb_ld(&bar[XB_TMO])) break; if (sp > XB_SPIN_CAP) { atomicAdd(&bar[XB_TMO], 1u); break; } }
    }
    nloc = mine > 0u ? mine : 1u; nx = cnt > 0u ? cnt : 1u;
}
__device__ __forceinline__ void xcd_barrier(const XcdBarrier& b) {
    asm volatile("s_waitcnt vmcnt(0)" ::: "memory");
    __syncthreads();
    if (threadIdx.x == 0) {
        unsigned* bar = b.bar;
        __builtin_amdgcn_s_waitcnt(0);
        unsigned nloc = b.st[0], nx = b.st[1];
        if (nloc == 0u) { xcd_barrier_complete(bar, b.x, nloc, nx); b.st[0] = nloc; b.st[1] = nx; }
        const unsigned old = xb_add(&bar[XB_XSUB(b.x)], 1u);
        const unsigned gen = old / nloc;
        if (old + 1u == (gen + 1u) * nloc) {
            __builtin_amdgcn_fence(__ATOMIC_RELEASE, "agent");
            asm volatile("s_waitcnt vmcnt(0)" ::: "memory");
            const unsigned og = xb_add(&bar[XB_TOP], 1u);
            const unsigned tg = og / nx;
            if (og + 1u == (tg + 1u) * nx) xb_add(&bar[XB_TOPGEN], 1u);
            else XB_SPIN(xb_ld(&bar[XB_TOPGEN]) == tg, bar);
            __builtin_amdgcn_fence(__ATOMIC_ACQUIRE, "agent");
            xb_add(&bar[XB_XGEN(b.x)], 1u);
            asm volatile("s_waitcnt vmcnt(0)" ::: "memory");
        } else {
            XB_SPIN(xb_ld(&bar[XB_XGEN(b.x)]) == gen, bar);
            __builtin_amdgcn_fence(__ATOMIC_ACQUIRE, "agent");
            asm volatile("s_waitcnt vmcnt(0)" ::: "memory");
        }
    }
    __syncthreads();
}

__device__ __forceinline__ void glds_saddr(unsigned voff, const char* sbase, unsigned lds_dst) { unsigned keep;
    asm volatile("s_mov_b32 %0, m0\n\ts_mov_b32 m0, %3\n\ts_nop 0\n\tglobal_load_lds_dwordx4 %1, %2\n\ts_mov_b32 m0, %0" : "=&s"(keep) : "v"(voff), "s"(sbase), "s"(lds_dst) : "memory"); }
namespace pg8 {
constexpr int BM = 256, BK = 64, HALF = 128, HTB = HALF * BK * 2, STAGE_BYTES = 8 * HTB, NXCD = 8, WGM = 8;
__host__ __device__ __forceinline__ int lds_byte(int r, int c) { const int st = (r >> 4) * 2 + (c >> 5), rr = r & 15, cc = c & 31, ob = rr * 64 + cc * 2; return st * 1024 + (ob ^ (((ob >> 9) & 1) << 5)); }
__host__ __device__ __forceinline__ void stage_rc(int b, int& R, int& C) { const int st = b / 1024, sb = b % 1024, swz = sb ^ (((sb >> 9) & 1) << 5); R = (st >> 1) * 16 + swz / 64; C = (st & 1) * 32 + (swz % 64) / 2; }
__host__ __device__ __forceinline__ int perm32(int rho) { const int n = rho >> 4, i = rho & 15; return 8 * (i >> 2) + 4 * n + (i & 3); }

struct Unit { int pm, pn, ex, ord; };

struct StaticOrder {
    int nM, nN, nwg, G, c;
    __device__ void init(int nM_, int nN_, int G_, int c_) { nM = nM_; nN = nN_; nwg = nM * nN; G = G_; c = c_; }
    __device__ bool next(int i, Unit& u) const {
        const long L = (long)i * G + c; if (L >= nwg) return false;
        int wgid = (int)L; { const int q = nwg / NXCD, r = nwg % NXCD, xcd = wgid % NXCD, off = wgid / NXCD; wgid = (xcd < r ? xcd * (q + 1) : r * (q + 1) + (xcd - r) * q) + off; }
        const int nig = WGM * nN, gid = wgid / nig, fm = gid * WGM, gsz = (nM - fm) < WGM ? (nM - fm) : WGM;
        u.pm = fm + ((wgid % nig) % gsz); u.pn = (wgid % nig) / gsz; u.ex = 0; u.ord = i; return true;
    }
};

struct ProbStatic {
    const char* A0; const char* B0; int lda, ldb, K;
    size_t a_pm_step, a_pn_step; int a_pn_shift; size_t b_pn_step, b_batch_step; int batch_div;
    StaticOrder S;
    __device__ __forceinline__ bool next(int i, Unit& u) const { return S.next(i, u); }
    __device__ __forceinline__ const char* a_base(const Unit& u) const { return A0 + (size_t)u.pm * a_pm_step + (size_t)(u.pn >> a_pn_shift) * a_pn_step; }
    __device__ __forceinline__ const char* b_base(const Unit& u) const { return B0 + (size_t)u.pn * b_pn_step + (size_t)(u.pm / batch_div) * b_batch_step; }
    __device__ __forceinline__ void a_offs(const Unit&, const int (&R)[2], const int (&C)[2], unsigned (&vo)[2][2]) const {
#pragma unroll
        for (int h = 0; h < 2; ++h)
#pragma unroll
            for (int i = 0; i < 2; ++i) vo[h][i] = (unsigned)((R[i] + HALF * h) * lda + C[i]) * 2u;
    }
};

template <bool GATHER> struct ProbMoe {
    const char* A0; const char* B0; int lda, ldb, K, npn; size_t b_e_step, b_pn_step;
    const LAS int* blkexp; const LAS int* tokbuf; int nblk, ntot, chunk, xcd, rank, nrank;
    __device__ __forceinline__ bool next(int i, Unit& u) const {
        const int idx = xcd * chunk + i * nrank + rank; int lim = (xcd + 1) * chunk; lim = lim < ntot ? lim : ntot;
        if (idx >= lim || i * nrank + rank >= chunk) return false;
        const int lb = idx / npn; u.pn = idx - lb * npn;
        if (lb < nblk) { u.pm = lb; u.ex = blkexp[lb]; } else { u.pm = RB_SHARED0 + (lb - nblk); u.ex = NE; }
        u.ord = i; return true;
    }
    __device__ __forceinline__ const char* a_base(const Unit& u) const { return GATHER ? A0 : A0 + (size_t)u.pm * BM * lda * 2; }
    __device__ __forceinline__ const char* b_base(const Unit& u) const { return B0 + (size_t)u.ex * b_e_step + (size_t)u.pn * b_pn_step; }
    __device__ __forceinline__ void a_offs(const Unit& u, const int (&R)[2], const int (&C)[2], unsigned (&vo)[2][2]) const {
#pragma unroll
        for (int h = 0; h < 2; ++h)
#pragma unroll
            for (int i = 0; i < 2; ++i) {
                if (GATHER) { const int tok = tokbuf[u.ord * 256 + R[i] + HALF * h]; vo[h][i] = (unsigned)(tok * lda + C[i]) * 2u; }
                else vo[h][i] = (unsigned)((R[i] + HALF * h) * lda + C[i]) * 2u;
            }
    }
};

struct EpiBf16 {
    static constexpr bool PERM = true, AFTER_DRAIN = false;
    bf16* O; int ldc; float scale;
    __device__ __forceinline__ void operator()(const f32x4 (&acc)[2][2][4][2], const Unit& u, int wr, int wc, int fr, int fq) const {
        const int row0 = u.pm * BM + wr * 64 + fr, col0 = u.pn * BM + wc * 32 + 8 * fq;
#pragma unroll
        for (int ai = 0; ai < 2; ++ai)
#pragma unroll
            for (int m = 0; m < 4; ++m) { bf16* rowp = O + (size_t)(row0 + ai * HALF + m * 16) * ldc + col0;
#pragma unroll
                for (int bj = 0; bj < 2; ++bj) { const f32x4 v0 = acc[ai][bj][m][0] * scale, v1 = acc[ai][bj][m][1] * scale;
                    u32x4 w; w.x = cvt_pk_bf16(v0[0], v0[1]); w.y = cvt_pk_bf16(v0[2], v0[3]); w.z = cvt_pk_bf16(v1[0], v1[1]); w.w = cvt_pk_bf16(v1[2], v1[3]);
                    *(u32x4*)(rowp + bj * HALF) = w; } }
    }
};
struct EpiResF32 {
    static constexpr bool PERM = false, AFTER_DRAIN = false;
    const float* base; float* Y; int ldc; float alpha;
    __device__ __forceinline__ void operator()(const f32x4 (&acc)[2][2][4][2], const Unit& u, int wr, int wc, int fr, int fq) const {
        const int row0 = u.pm * BM + wr * 64 + fr, col0 = u.pn * BM + wc * 32 + 4 * fq;
#pragma unroll
        for (int ai = 0; ai < 2; ++ai)
#pragma unroll
            for (int m = 0; m < 4; ++m) { const size_t off = (size_t)(row0 + ai * HALF + m * 16) * ldc + col0;
#pragma unroll
                for (int bj = 0; bj < 2; ++bj)
#pragma unroll
                    for (int n = 0; n < 2; ++n) { const f32x4 b = *(const f32x4*)(base + off + bj * HALF + n * 16); *(f32x4*)(Y + off + bj * HALF + n * 16) = b * alpha + acc[ai][bj][m][n]; } }
    }
};
struct EpiSwiGLU {
    static constexpr bool PERM = true, AFTER_DRAIN = false;
    bf16* Hd; const LAS float* gatebuf;
    __device__ __forceinline__ void operator()(const f32x4 (&acc)[2][2][4][2], const Unit& u, int wr, int wc, int fr, int fq) const {
        const int r0 = wr * 64 + fr, col0 = u.pn * HALF + wc * 32 + 8 * fq;
#pragma unroll
        for (int ai = 0; ai < 2; ++ai)
#pragma unroll
            for (int m = 0; m < 4; ++m) { const int r = r0 + ai * HALF + m * 16; const float gt = gatebuf[u.ord * 256 + r];
                float o[8];
#pragma unroll
                for (int n = 0; n < 2; ++n)
#pragma unroll
                    for (int e = 0; e < 4; ++e) { const float g = acc[ai][0][m][n][e], up = acc[ai][1][m][n][e];
                        const float sg = g * __builtin_amdgcn_rcpf(1.0f + __builtin_amdgcn_exp2f(-g * LOG2E)); o[n * 4 + e] = sg * up * gt; }
                u32x4 w; w.x = cvt_pk_bf16(o[0], o[1]); w.y = cvt_pk_bf16(o[2], o[3]); w.z = cvt_pk_bf16(o[4], o[5]); w.w = cvt_pk_bf16(o[6], o[7]);
                *(u32x4*)(Hd + (size_t)(u.pm * BM + r) * DE + col0) = w; }
    }
};
struct EpiSwiGLU8 {
    static constexpr bool PERM = true, AFTER_DRAIN = false;
    unsigned char* Hd; const LAS float* gatebuf;
    __device__ __forceinline__ void operator()(const f32x4 (&acc)[2][2][4][2], const Unit& u, int wr, int wc, int fr, int fq) const {
        const int r0 = wr * 64 + fr, col0 = u.pn * HALF + wc * 32 + 8 * fq;
#pragma unroll
        for (int ai = 0; ai < 2; ++ai)
#pragma unroll
            for (int m = 0; m < 4; ++m) { const int r = r0 + ai * HALF + m * 16; const float gt = gatebuf[u.ord * 256 + r] * 16.0f;
                float o[8];
#pragma unroll
                for (int n = 0; n < 2; ++n)
#pragma unroll
                    for (int e = 0; e < 4; ++e) { const float g = acc[ai][0][m][n][e] * 0.015625f, up = acc[ai][1][m][n][e] * 0.015625f;
                        const float sg = g * __builtin_amdgcn_rcpf(1.0f + __builtin_amdgcn_exp2f(-g * LOG2E)); o[n * 4 + e] = sg * up * gt; }
                int w0 = 0, w1 = 0;
                w0 = __builtin_amdgcn_cvt_pk_fp8_f32(o[0], o[1], w0, false); w0 = __builtin_amdgcn_cvt_pk_fp8_f32(o[2], o[3], w0, true);
                w1 = __builtin_amdgcn_cvt_pk_fp8_f32(o[4], o[5], w1, false); w1 = __builtin_amdgcn_cvt_pk_fp8_f32(o[6], o[7], w1, true);
                u32x2 w; w.x = (unsigned)w0; w.y = (unsigned)w1;
                *(u32x2*)(Hd + (size_t)(u.pm * BM + r) * DE + col0) = w; }
    }
};
struct EpiSoftmax {
    static constexpr bool PERM = true, AFTER_DRAIN = true;
    bf16* O; int ldc; float scale2;
    __device__ __forceinline__ void operator()(const f32x4 (&)[2][2][4][2], const Unit&, int, int, int, int) const {}
    __device__ __forceinline__ void fused(f32x4 (&acc)[2][2][4][2], const Unit& u, int wr, int wc, int fr, int fq, lds_u8* lds, int wid, int lane) const {
        LAS float* X = (LAS float*)lds;
        LAS float* Z = (LAS float*)(lds + 4096);
        float mx[2][4];
#pragma unroll
        for (int ai = 0; ai < 2; ++ai)
#pragma unroll
            for (int m = 0; m < 4; ++m) { float v = -3.0e38f;
#pragma unroll
                for (int bj = 0; bj < 2; ++bj)
#pragma unroll
                    for (int n = 0; n < 2; ++n) { acc[ai][bj][m][n] = acc[ai][bj][m][n] * scale2; const f32x4 x = acc[ai][bj][m][n]; v = fmaxf(v, fmaxf(fmaxf(x[0], x[1]), fmaxf(x[2], x[3]))); }
                v = fmaxf(v, __shfl_xor(v, 16)); v = fmaxf(v, __shfl_xor(v, 32));
                if (fq == 0) X[(ai * HALF + wr * 64 + m * 16 + fr) * 4 + wc] = v; }
        asm volatile("s_waitcnt lgkmcnt(0)" ::: "memory"); __builtin_amdgcn_s_barrier(); asm volatile("" ::: "memory");
#pragma unroll
        for (int ai = 0; ai < 2; ++ai)
#pragma unroll
            for (int m = 0; m < 4; ++m) { const int r = ai * HALF + wr * 64 + m * 16 + fr; const f32x4 t = *(const LAS f32x4*)(X + r * 4);
                const float mm = fmaxf(fmaxf(t[0], t[1]), fmaxf(t[2], t[3])); mx[ai][m] = mm; float s = 0.f;
#pragma unroll
                for (int bj = 0; bj < 2; ++bj)
#pragma unroll
                    for (int n = 0; n < 2; ++n) { f32x4 x = acc[ai][bj][m][n];
#pragma unroll
                        for (int e = 0; e < 4; ++e) x[e] = __builtin_amdgcn_exp2f(x[e] - mm);
                        acc[ai][bj][m][n] = x; s += (x[0] + x[1]) + (x[2] + x[3]); }
                s += __shfl_xor(s, 16); s += __shfl_xor(s, 32);
                if (fq == 0) Z[r * 4 + wc] = s; }
        asm volatile("s_waitcnt lgkmcnt(0)" ::: "memory"); __builtin_amdgcn_s_barrier(); asm volatile("" ::: "memory");
        const int row0 = u.pm * BM + wr * 64 + fr, col0 = u.pn * BM + wc * 32 + 8 * fq;
#pragma unroll
        for (int ai = 0; ai < 2; ++ai)
#pragma unroll
            for (int m = 0; m < 4; ++m) { const int r = ai * HALF + wr * 64 + m * 16 + fr; const f32x4 t = *(const LAS f32x4*)(Z + r * 4);
                const float inv = 1.0f / ((t[0] + t[1]) + (t[2] + t[3]));
                bf16* rowp = O + (size_t)(row0 + ai * HALF + m * 16) * ldc + col0;
#pragma unroll
                for (int bj = 0; bj < 2; ++bj) { const f32x4 v0 = acc[ai][bj][m][0] * inv, v1 = acc[ai][bj][m][1] * inv;
                    u32x4 w; w.x = cvt_pk_bf16(v0[0], v0[1]); w.y = cvt_pk_bf16(v0[2], v0[3]); w.z = cvt_pk_bf16(v1[0], v1[1]); w.w = cvt_pk_bf16(v1[2], v1[3]);
                    *(u32x4*)(rowp + bj * HALF) = w; } }
        (void)mx; (void)wid; (void)lane;
    }
};

template <class Epi, class Prob, bool ALIGN_EPI, bool FP8 = false>
__device__ __forceinline__ void gemm_phase(lds_u8* lds, const Prob& P, const Epi& E, const int tid) {
    const int wid = __builtin_amdgcn_readfirstlane(tid >> 6), lane = tid & 63, wr = wid >> 2, wc = wid & 3, fr = lane & 15, fq = lane >> 4;
    const int nt = P.K / BK;
    int Rr[2], Cc[2]; unsigned voffB[2];
#pragma unroll
    for (int i = 0; i < 2; ++i) { stage_rc(tid * 16 + i * 8192, Rr[i], Cc[i]); const int Rb = Epi::PERM ? ((Rr[i] & ~31) + perm32(Rr[i] & 31)) : Rr[i];
        voffB[i] = (unsigned)(Rb * P.ldb + Cc[i]) * 2u; }
    const size_t kstep = (size_t)(BK * 2);
    const size_t hstepB = (size_t)HALF * P.ldb * 2;
    const unsigned ldsw = (unsigned)wid * 1024u;
    const unsigned ldsb = (unsigned)__builtin_amdgcn_readfirstlane((int)(unsigned)(size_t)lds);
    const int aoff = lds_byte(wr * 64 + fr, fq * 8), boff = lds_byte(wc * 32 + fr, fq * 8);
#define PG8_SA(b, h) (((b) * 2 + (h)) * HTB)
#define PG8_SB(b, h) ((4 + (b) * 2 + (h)) * HTB)
#define PG8_STAGE(bufoff, gbase, voff) do { _Pragma("unroll") for (int _i = 0; _i < 2; ++_i) \
        glds_saddr((voff)[_i], (const char*)(gbase), ldsb + (unsigned)(bufoff) + ldsw + (unsigned)(_i * 8192)); } while (0)
#define PG8_LDA(dst, b, h) do { _Pragma("unroll") for (int m = 0; m < 4; ++m) _Pragma("unroll") for (int k = 0; k < 2; ++k) dst[m][k] = *(const LAS bf16x8*)(lds + PG8_SA(b, h) + aoff + m * 2048 + k * 1024); } while (0)
#define PG8_LDB(dst, b, h) do { _Pragma("unroll") for (int n = 0; n < 2; ++n) _Pragma("unroll") for (int k = 0; k < 2; ++k) dst[n][k] = *(const LAS bf16x8*)(lds + PG8_SB(b, h) + boff + n * 2048 + k * 1024); } while (0)
#define PG8_CAT(x0, x1) __builtin_shufflevector(__builtin_bit_cast(i32x4, x0), __builtin_bit_cast(i32x4, x1), 0, 1, 2, 3, 4, 5, 6, 7)
#define PG8_MMA(ai, bj, At, Bt) do { __builtin_amdgcn_s_setprio(1); \
        if constexpr (FP8) { _Pragma("unroll") for (int m = 0; m < 4; ++m) _Pragma("unroll") for (int n = 0; n < 2; ++n) \
            asm volatile("v_mfma_scale_f32_16x16x128_f8f6f4 %0, %1, %2, %0, %3, %3 op_sel_hi:[0,0,0]" : "+v"(acc[ai][bj][m][n]) : "v"(PG8_CAT(Bt[n][0], Bt[n][1])), "v"(PG8_CAT(At[m][0], At[m][1])), "v"(0x7f7f7f7f)); } \
        else { _Pragma("unroll") for (int m = 0; m < 4; ++m) _Pragma("unroll") for (int n = 0; n < 2; ++n) _Pragma("unroll") for (int k = 0; k < 2; ++k) \
            acc[ai][bj][m][n] = __builtin_amdgcn_mfma_f32_16x16x32_bf16(Bt[n][k], At[m][k], acc[ai][bj][m][n], 0, 0, 0); } \
        __builtin_amdgcn_s_setprio(0); } while (0)
#define PG8_WAIT_V(n) asm volatile("s_waitcnt vmcnt(" #n ")" ::: "memory")
#define PG8_WAIT_L(n) asm volatile("s_waitcnt lgkmcnt(" #n ")" ::: "memory")
#define PG8_BAR __builtin_amdgcn_s_barrier()
#define PG8_SCHED __builtin_amdgcn_sched_barrier(0)
    Unit cur, nxt; int ui = 0;
    if (!P.next(0, cur)) return;
    f32x4 acc[2][2][4][2];
#pragma unroll
    for (int a = 0; a < 2; ++a)
#pragma unroll
        for (int b = 0; b < 2; ++b)
#pragma unroll
            for (int m = 0; m < 4; ++m)
#pragma unroll
                for (int n = 0; n < 2; ++n) acc[a][b][m][n] = (f32x4){0.f, 0.f, 0.f, 0.f};
    bf16x8 At[4][2], B0[2][2], B1[2][2];
    unsigned vA[2][2], nvA[2][2];
    P.a_offs(cur, Rr, Cc, vA);
    const char* cA = P.a_base(cur); const char* cB = P.b_base(cur);
    PG8_STAGE(PG8_SB(0, 0), cB, voffB); PG8_STAGE(PG8_SB(0, 1), cB + hstepB, voffB); PG8_STAGE(PG8_SA(0, 0), cA, vA[0]); PG8_STAGE(PG8_SA(0, 1), cA, vA[1]);
    if (wr == 1) PG8_BAR;
    PG8_WAIT_V(2); PG8_BAR;
    PG8_STAGE(PG8_SB(1, 0), cB + kstep, voffB); PG8_STAGE(PG8_SA(1, 0), cA + kstep, vA[0]); PG8_STAGE(PG8_SB(1, 1), cB + hstepB + kstep, voffB);
    PG8_WAIT_V(6); PG8_BAR;
    for (;;) {
        const bool has_next = P.next(ui + 1, nxt);
        const char* nA = cA; const char* nB = cB;
#pragma unroll
        for (int h = 0; h < 2; ++h)
#pragma unroll
            for (int i = 0; i < 2; ++i) nvA[h][i] = vA[h][i];
        if (has_next) { nA = P.a_base(nxt); nB = P.b_base(nxt); P.a_offs(nxt, Rr, Cc, nvA); }
        for (int t = 0; t < nt; t += 2) {
            const bool last = (t == nt - 2);
            const char* a1 = cA + (size_t)(t + 1) * kstep;
            const char* a2 = last ? nA : cA + (size_t)(t + 2) * kstep; const char* b2 = last ? nB : cB + (size_t)(t + 2) * kstep;
            const char* a3 = a2 + kstep; const char* b3 = b2 + kstep;
            unsigned o2a[2], o2b[2];
#pragma unroll
            for (int i = 0; i < 2; ++i) { o2a[i] = last ? nvA[0][i] : vA[0][i]; o2b[i] = last ? nvA[1][i] : vA[1][i]; }
            PG8_LDB(B0, 0, 0); PG8_LDB(B1, 0, 1); PG8_SCHED; PG8_LDA(At, 0, 0); PG8_STAGE(PG8_SA(1, 1), a1, vA[1]);
            PG8_WAIT_V(8); PG8_WAIT_L(0); PG8_BAR; PG8_MMA(0, 0, At, B0); PG8_MMA(0, 1, At, B1); PG8_BAR; PG8_SCHED;
            PG8_LDA(At, 0, 1); PG8_STAGE(PG8_SB(0, 0), b2, voffB); PG8_STAGE(PG8_SB(0, 1), b2 + hstepB, voffB); PG8_STAGE(PG8_SA(0, 0), a2, o2a);
            PG8_WAIT_V(8); PG8_WAIT_L(0); PG8_BAR; PG8_MMA(1, 0, At, B0); PG8_MMA(1, 1, At, B1); PG8_BAR; PG8_SCHED;
            PG8_LDB(B0, 1, 0); PG8_LDB(B1, 1, 1); PG8_SCHED; PG8_LDA(At, 1, 0); PG8_STAGE(PG8_SA(0, 1), a2, o2b);
            PG8_WAIT_V(8); PG8_WAIT_L(0); PG8_BAR; PG8_MMA(0, 0, At, B0); PG8_MMA(0, 1, At, B1); PG8_BAR; PG8_SCHED;
            PG8_LDA(At, 1, 1); PG8_STAGE(PG8_SB(1, 0), b3, voffB); PG8_STAGE(PG8_SB(1, 1), b3 + hstepB, voffB); PG8_STAGE(PG8_SA(1, 0), a3, o2a);
            PG8_WAIT_V(8); PG8_WAIT_L(0); PG8_BAR; PG8_MMA(1, 0, At, B0); PG8_MMA(1, 1, At, B1); PG8_BAR; PG8_SCHED;
        }
        if constexpr (ALIGN_EPI) { if (wr == 0) PG8_BAR; }
        if constexpr (!Epi::AFTER_DRAIN) { E(acc, cur, wr, wc, fr, fq); }
        if (!has_next) break;
#pragma unroll
        for (int a = 0; a < 2; ++a)
#pragma unroll
            for (int b = 0; b < 2; ++b)
#pragma unroll
                for (int m = 0; m < 4; ++m)
#pragma unroll
                    for (int n = 0; n < 2; ++n) acc[a][b][m][n] = (f32x4){0.f, 0.f, 0.f, 0.f};
        cur = nxt; cA = nA; cB = nB; ++ui;
#pragma unroll
        for (int h = 0; h < 2; ++h)
#pragma unroll
            for (int i = 0; i < 2; ++i) vA[h][i] = nvA[h][i];
        if constexpr (ALIGN_EPI) { if (wr == 1) PG8_BAR; }
    }
    PG8_WAIT_V(0);
    if constexpr (!ALIGN_EPI) { if (wr == 0) PG8_BAR; }
    PG8_BAR;
    if constexpr (Epi::AFTER_DRAIN) { E.fused(acc, cur, wr, wc, fr, fq, lds, wid, lane); }
#undef PG8_SA
#undef PG8_SB
#undef PG8_STAGE
#undef PG8_LDA
#undef PG8_LDB
#undef PG8_MMA
#undef PG8_CAT
#undef PG8_WAIT_V
#undef PG8_WAIT_L
#undef PG8_BAR
#undef PG8_SCHED
}
}

constexpr int NWAVES = 8;
struct Args {
    const float* in[25]; float* out; unsigned char* ws; int ph_lo, ph_hi;
};
static_assert(sizeof(Args) == 224, "Args layout (kernarg offsets in ka_ptr users)");
struct Frame {
    lds_u8* lds; volatile LAS unsigned* MISC; gu32* ctl;
    int tid, lane, wave, G, bid;
};
__device__ __forceinline__ void relaunder(Frame& F) { int t = threadIdx.x; asm volatile("" : "+v"(t)); F.tid = t; F.lane = t & 63; F.wave = __builtin_amdgcn_readfirstlane(t >> 6); int b = blockIdx.x; asm volatile("" : "+s"(b)); F.bid = b; }


typedef const unsigned char* cptr_t;
__device__ __forceinline__ cptr_t ka_ptr(int off) { const __attribute__((address_space(4))) unsigned char* p = (const __attribute__((address_space(4))) unsigned char*)__builtin_amdgcn_kernarg_segment_ptr(); asm volatile("" : "+s"(p)); return *(const __attribute__((address_space(4))) cptr_t*)(p + off); }
#define INP(i) ((const float*)ka_ptr(8 * (i)))
#define OUTP ((float*)ka_ptr(200))
#define WSP ((unsigned char*)ka_ptr(208))

struct Row { f32x4 v[8]; };
__device__ __forceinline__ void row_load_f32(Row& r, const float* p, int lane) {
#pragma unroll
    for (int j = 0; j < 4; ++j) { const f32x4* q = (const f32x4*)(p + 512 * j + 8 * lane); r.v[2 * j] = q[0]; r.v[2 * j + 1] = q[1]; }
}
__device__ __forceinline__ void row_store_f32(const Row& r, float* p, int lane) {
#pragma unroll
    for (int j = 0; j < 4; ++j) { f32x4* q = (f32x4*)(p + 512 * j + 8 * lane); q[0] = r.v[2 * j]; q[1] = r.v[2 * j + 1]; }
}
__device__ __forceinline__ void row_store_bf16(const Row& r, bf16* p, int lane) {
#pragma unroll
    for (int j = 0; j < 4; ++j) { const f32x4 a = r.v[2 * j], b = r.v[2 * j + 1]; u32x4 w; w.x = cvt_pk_bf16(a[0], a[1]); w.y = cvt_pk_bf16(a[2], a[3]); w.z = cvt_pk_bf16(b[0], b[1]); w.w = cvt_pk_bf16(b[2], b[3]);
        *(u32x4*)(p + 512 * j + 8 * lane) = w; }
}
__device__ __forceinline__ void row_add_bf16(Row& r, const bf16* p, int lane) {
#pragma unroll
    for (int j = 0; j < 4; ++j) { const u32x4 w = *(const u32x4*)(p + 512 * j + 8 * lane);
        r.v[2 * j] += (f32x4){bf_lo(w.x), bf_hi(w.x), bf_lo(w.y), bf_hi(w.y)}; r.v[2 * j + 1] += (f32x4){bf_lo(w.z), bf_hi(w.z), bf_lo(w.w), bf_hi(w.w)}; }
}
__device__ __forceinline__ void row_layernorm(Row& r, const Row& g, const Row& b) {
    float s = 0.f;
#pragma unroll
    for (int i = 0; i < 8; ++i) s += (r.v[i][0] + r.v[i][1]) + (r.v[i][2] + r.v[i][3]);
    const float mean = wave_sum(s) * (1.0f / D); float s2 = 0.f;
#pragma unroll
    for (int i = 0; i < 8; ++i) { r.v[i] = r.v[i] - mean; s2 += (r.v[i][0] * r.v[i][0] + r.v[i][1] * r.v[i][1]) + (r.v[i][2] * r.v[i][2] + r.v[i][3] * r.v[i][3]); }
    const float rstd = 1.0f / sqrtf(wave_sum(s2) * (1.0f / D) + LN_EPS);
#pragma unroll
    for (int i = 0; i < 8; ++i) r.v[i] = r.v[i] * rstd * g.v[i] + b.v[i];
}

__device__ __forceinline__ void tr_item(const float* W, int N, int k0, int n0, bf16* WT, size_t orow0, int K, LAS float* scr, int lane) {
    f32x4 v[16];
#pragma unroll
    for (int i = 0; i < 16; ++i) v[i] = *(const f32x4*)(W + (size_t)(k0 + 4 * i + (lane >> 4)) * N + n0 + 4 * (lane & 15));
#pragma unroll
    for (int i = 0; i < 16; ++i) { LAS float* s = scr + (4 * i + (lane >> 4)) * 65 + 4 * (lane & 15); s[0] = v[i][0]; s[1] = v[i][1]; s[2] = v[i][2]; s[3] = v[i][3]; }
    LDS_WAIT(); asm volatile("" ::: "memory");
    const int c = lane >> 3;
#pragma unroll
    for (int p = 0; p < 8; ++p) { const int n = 8 * p + (lane & 7); const LAS float* s = scr + (8 * c) * 65 + n;
        u32x4 o; o.x = cvt_pk_bf16(s[0 * 65], s[1 * 65]); o.y = cvt_pk_bf16(s[2 * 65], s[3 * 65]); o.z = cvt_pk_bf16(s[4 * 65], s[5 * 65]); o.w = cvt_pk_bf16(s[6 * 65], s[7 * 65]);
        *(u32x4*)(WT + (orow0 + n) * (size_t)K + k0 + 8 * c) = o; }
    LDS_WAIT(); asm volatile("" ::: "memory");
}
__device__ __forceinline__ void tr_item8(const float* W, int N, int k0, int n0, unsigned char* WT, size_t orow0, int K, LAS float* scr, int lane, float sc) {
    f32x4 v[16];
#pragma unroll
    for (int i = 0; i < 16; ++i) v[i] = *(const f32x4*)(W + (size_t)(k0 + 4 * i + (lane >> 4)) * N + n0 + 4 * (lane & 15));
#pragma unroll
    for (int i = 0; i < 16; ++i) { LAS float* s = scr + (4 * i + (lane >> 4)) * 65 + 4 * (lane & 15); s[0] = v[i][0] * sc; s[1] = v[i][1] * sc; s[2] = v[i][2] * sc; s[3] = v[i][3] * sc; }
    LDS_WAIT(); asm volatile("" ::: "memory");
    const int c = lane >> 4;
#pragma unroll
    for (int p = 0; p < 4; ++p) { const int n = 16 * p + (lane & 15); const LAS float* s = scr + (16 * c) * 65 + n;
        int w[4];
#pragma unroll
        for (int q = 0; q < 4; ++q) { int x = 0; x = __builtin_amdgcn_cvt_pk_fp8_f32(s[(4 * q + 0) * 65], s[(4 * q + 1) * 65], x, false); x = __builtin_amdgcn_cvt_pk_fp8_f32(s[(4 * q + 2) * 65], s[(4 * q + 3) * 65], x, true); w[q] = x; }
        u32x4 o; o.x = (unsigned)w[0]; o.y = (unsigned)w[1]; o.z = (unsigned)w[2]; o.w = (unsigned)w[3];
        *(u32x4*)(WT + (orow0 + n) * (size_t)K + k0 + 16 * c) = o; }
    LDS_WAIT(); asm volatile("" ::: "memory");
}
template <bool GU> __device__ __forceinline__ void tr_matrix_item(const float* W, int K, int N, bf16* WT, size_t orow_base, int item, LAS float* scr, int lane) {
    const int nblk = N / 64, kb = item / nblk, nb = item % nblk, n0 = nb * 64;
    const size_t orow0 = orow_base + (GU ? (size_t)((n0 >> 7) * 256 + (n0 & 127)) : (size_t)n0);
    tr_item(W, N, kb * 64, n0, WT, orow0, K, scr, lane);
}

template <bool GU> __device__ __forceinline__ void tr_matrix_item8(const float* W, int K, int N, unsigned char* WT, size_t orow_base, int item, LAS float* scr, int lane, float sc) {
    const int nblk = N / 64, kb = item / nblk, nb = item % nblk, n0 = nb * 64;
    const size_t orow0 = orow_base + (GU ? (size_t)((n0 >> 7) * 256 + (n0 & 127)) : (size_t)n0);
    tr_item8(W, N, kb * 64, n0, WT, orow0, K, scr, lane, sc);
}

constexpr int ATT_ROWB = 160;
constexpr int ATT_TILE = 272 * ATT_ROWB;
typedef short v4i16_t __attribute__((ext_vector_type(4)));
__device__ __forceinline__ s16x4 vtr(const lds_u8* p) { return __builtin_bit_cast(s16x4, __builtin_amdgcn_ds_read_tr16_b64_v4i16((LAS v4i16_t*)p)); }
__device__ __forceinline__ void attn_phase(Frame& F, const bf16* proj, const float* sinks, bf16* oA, bf16* oB, float* lseB) {
    lds_u8* Kt = F.lds; lds_u8* Vt = F.lds + ATT_TILE;
    const int tid = F.tid, wid = F.wave, lane = F.lane, fr = lane & 15, fq = lane >> 4;
    for (int i = tid; i < 2 * 640; i += NWAVES * 64) { lds_u8* base = (i >= 640) ? Vt : Kt; *(LAS unsigned*)(base + 256 * ATT_ROWB + (i % 640) * 4) = 0u; }
    __syncthreads();
    for (int u = F.bid; u < 8192; u += F.G) {
        const int kind = u >> 11, rem = u & 2047, b = rem >> 9, h = (rem >> 5) & 15, j32 = rem & 31;
        const int dsh = (kind <= 1) ? 0 : (kind == 2 ? 2 : 4), d = 1 << dsh, nbpr = 32 >> dsh, r = j32 / nbpr, nb = j32 % nbpr;
        const int qcol = (kind == 0) ? h * 64 : 1280 + h * 64, kcol = (kind == 0) ? 1024 + (h >> 3) * 64 : 2304 + h * 64, vcol = (kind == 0) ? 1152 + (h >> 3) * 64 : 3328 + h * 64;
        const int max_off = (kind == 0) ? 127 : 128;
        const float slope2 = __builtin_amdgcn_exp2f(-0.5f * (float)(h + 1)) * (float)d * LOG2E;
        const float sink2 = (kind == 0) ? sinks[h] * LOG2E : -__builtin_inff();
        const size_t tok0 = (size_t)b * SEQ + r;
#pragma unroll
        for (int i = 0; i < 4; ++i) { const int row = (tid >> 3) + 64 * i, c = tid & 7; int t = (nb - 1) * 128 + row; t = t < 0 ? 0 : t;
            const bf16* src = proj + (tok0 + (size_t)d * t) * INW + c * 8;
            const u32x4 kv = *(const u32x4*)(src + kcol), vv = *(const u32x4*)(src + vcol);
            *(LAS u32x4*)(Kt + row * ATT_ROWB + c * 16) = kv; *(LAS u32x4*)(Vt + row * ATT_ROWB + c * 16) = vv; }
        const int tq = nb * 128 + wid * 16 + fr; const size_t tokq = tok0 + (size_t)d * tq;
        const bf16x8 q0 = *(const bf16x8*)(proj + tokq * INW + qcol + 8 * fq), q1 = *(const bf16x8*)(proj + tokq * INW + qcol + 32 + 8 * fq);
        __syncthreads();
        f32x4 s[9];
#pragma unroll
        for (int j = 0; j < 9; ++j) { const lds_u8* kp = Kt + (16 * (wid + j) + fr) * ATT_ROWB + fq * 16;
            const bf16x8 a0 = *(const LAS bf16x8*)kp, a1 = *(const LAS bf16x8*)(kp + 64);
            f32x4 z = (f32x4){0.f, 0.f, 0.f, 0.f}; z = __builtin_amdgcn_mfma_f32_16x16x32_bf16(a0, q0, z, 0, 0, 0); s[j] = __builtin_amdgcn_mfma_f32_16x16x32_bf16(a1, q1, z, 0, 0, 0); }
        float mx = -__builtin_inff();
#pragma unroll
        for (int j = 0; j < 9; ++j)
#pragma unroll
            for (int e = 0; e < 4; ++e) { const int delta = 128 + fr - 16 * j - 4 * fq - e; const int tk = (nb - 1) * 128 + 16 * (wid + j) + 4 * fq + e;
                const bool valid = (delta >= 0) && (delta <= max_off) && (tk >= 0);
                const float v = valid ? (s[j][e] * (0.125f * LOG2E) - slope2 * (float)delta) : -__builtin_inff(); s[j][e] = v; mx = fmaxf(mx, v); }
        mx = fmaxf(mx, __shfl_xor(mx, 16)); mx = fmaxf(mx, __shfl_xor(mx, 32)); mx = fmaxf(mx, sink2);
        float sum = 0.f;
#pragma unroll
        for (int j = 0; j < 9; ++j)
#pragma unroll
            for (int e = 0; e < 4; ++e) { const float p = __builtin_amdgcn_exp2f(s[j][e] - mx); s[j][e] = p; sum += p; }
        sum += __shfl_xor(sum, 16); sum += __shfl_xor(sum, 32); sum += __builtin_amdgcn_exp2f(sink2 - mx);
        bf16x8 pb[5];
#pragma unroll
        for (int ks = 0; ks < 5; ++ks) { u32x4 w; w.x = cvt_pk_bf16(s[2 * ks][0], s[2 * ks][1]); w.y = cvt_pk_bf16(s[2 * ks][2], s[2 * ks][3]);
            if (ks < 4) { w.z = cvt_pk_bf16(s[2 * ks + 1][0], s[2 * ks + 1][1]); w.w = cvt_pk_bf16(s[2 * ks + 1][2], s[2 * ks + 1][3]); } else { w.z = 0u; w.w = 0u; }
            pb[ks] = __builtin_bit_cast(bf16x8, w); }
        f32x4 o[4];
#pragma unroll
        for (int dt = 0; dt < 4; ++dt) { f32x4 z = (f32x4){0.f, 0.f, 0.f, 0.f};
#pragma unroll
            for (int ks = 0; ks < 5; ++ks) { const lds_u8* vp = Vt + (16 * (wid + 2 * ks) + 4 * fq + (fr >> 2)) * ATT_ROWB + (16 * dt + 4 * (fr & 3)) * 2;
                const s16x4 v0 = vtr(vp), v1 = vtr(vp + 16 * ATT_ROWB);
                const bf16x8 a = (bf16x8){v0[0], v0[1], v0[2], v0[3], v1[0], v1[1], v1[2], v1[3]};
                z = __builtin_amdgcn_mfma_f32_16x16x32_bf16(a, pb[ks], z, 0, 0, 0); }
            o[dt] = z; }
        const float inv = 1.0f / sum;
        bf16* orow = ((kind == 0) ? oA : oB + (size_t)(kind - 1) * M * 1024) + tokq * 1024 + h * 64 + 4 * fq;
#pragma unroll
        for (int dt = 0; dt < 4; ++dt) { u32x2 w; w.x = cvt_pk_bf16(o[dt][0] * inv, o[dt][1] * inv); w.y = cvt_pk_bf16(o[dt][2] * inv, o[dt][3] * inv); *(u32x2*)(orow + 16 * dt) = w; }
        if (kind > 0 && fq == 0) lseB[((size_t)(kind - 1) * M + tokq) * 16 + h] = mx + __builtin_amdgcn_logf(sum);
        __syncthreads();
    }
}

__device__ __forceinline__ void merge_phase(Frame& F, const bf16* oA, const bf16* oB, const float* lseB, const float* ga, const float* gb, bf16* mixed) {
    const int lane = F.lane, gw = F.bid * NWAVES + F.wave, NGW = F.G * NWAVES;
    f32x4 gA[4], gB[4];
#pragma unroll
    for (int jj = 0; jj < 2; ++jj) { gA[2 * jj] = *(const f32x4*)(ga + 512 * jj + 8 * lane); gA[2 * jj + 1] = *(const f32x4*)(ga + 512 * jj + 8 * lane + 4);
        gB[2 * jj] = *(const f32x4*)(gb + 512 * jj + 8 * lane); gB[2 * jj + 1] = *(const f32x4*)(gb + 512 * jj + 8 * lane + 4); }
    for (int t = gw; t < M; t += NGW) {
        f32x4 a[4], bb[4];
        float ssa = 0.f, ssb = 0.f;
#pragma unroll
        for (int jj = 0; jj < 2; ++jj) {
            const int e0 = 512 * jj + 8 * lane, hh = e0 >> 6;
            const u32x4 w = *(const u32x4*)(oA + (size_t)t * 1024 + e0);
            a[2 * jj] = (f32x4){bf_lo(w.x), bf_hi(w.x), bf_lo(w.y), bf_hi(w.y)}; a[2 * jj + 1] = (f32x4){bf_lo(w.z), bf_hi(w.z), bf_lo(w.w), bf_hi(w.w)};
            float l0 = lseB[((size_t)0 * M + t) * 16 + hh], l1 = lseB[((size_t)1 * M + t) * 16 + hh], l2 = lseB[((size_t)2 * M + t) * 16 + hh];
            const float lm = fmaxf(l0, fmaxf(l1, l2)); l0 = __builtin_amdgcn_exp2f(l0 - lm); l1 = __builtin_amdgcn_exp2f(l1 - lm); l2 = __builtin_amdgcn_exp2f(l2 - lm);
            const float li = 1.0f / (l0 + l1 + l2); l0 *= li; l1 *= li; l2 *= li;
            const u32x4 w0 = *(const u32x4*)(oB + ((size_t)0 * M + t) * 1024 + e0), w1 = *(const u32x4*)(oB + ((size_t)1 * M + t) * 1024 + e0), w2 = *(const u32x4*)(oB + ((size_t)2 * M + t) * 1024 + e0);
            bb[2 * jj] = (f32x4){bf_lo(w0.x), bf_hi(w0.x), bf_lo(w0.y), bf_hi(w0.y)} * l0 + (f32x4){bf_lo(w1.x), bf_hi(w1.x), bf_lo(w1.y), bf_hi(w1.y)} * l1 + (f32x4){bf_lo(w2.x), bf_hi(w2.x), bf_lo(w2.y), bf_hi(w2.y)} * l2;
            bb[2 * jj + 1] = (f32x4){bf_lo(w0.z), bf_hi(w0.z), bf_lo(w0.w), bf_hi(w0.w)} * l0 + (f32x4){bf_lo(w1.z), bf_hi(w1.z), bf_lo(w1.w), bf_hi(w1.w)} * l1 + (f32x4){bf_lo(w2.z), bf_hi(w2.z), bf_lo(w2.w), bf_hi(w2.w)} * l2;
        }
#pragma unroll
        for (int i = 0; i < 4; ++i) { ssa += (a[i][0] * a[i][0] + a[i][1] * a[i][1]) + (a[i][2] * a[i][2] + a[i][3] * a[i][3]); ssb += (bb[i][0] * bb[i][0] + bb[i][1] * bb[i][1]) + (bb[i][2] * bb[i][2] + bb[i][3] * bb[i][3]); }
        const float ra = 1.0f / sqrtf(wave_sum(ssa) * (1.0f / 1024.0f) + RMS_EPS), rb = 1.0f / sqrtf(wave_sum(ssb) * (1.0f / 1024.0f) + RMS_EPS);
#pragma unroll
        for (int jj = 0; jj < 2; ++jj) { const int e0 = 512 * jj + 8 * lane;
            const f32x4 x0 = a[2 * jj] * ra * gA[2 * jj], x1 = a[2 * jj + 1] * ra * gA[2 * jj + 1], y0 = bb[2 * jj] * rb * gB[2 * jj], y1 = bb[2 * jj + 1] * rb * gB[2 * jj + 1];
            u32x4 w; w.x = cvt_pk_bf16(x0[0], x0[1]); w.y = cvt_pk_bf16(x0[2], x0[3]); w.z = cvt_pk_bf16(x1[0], x1[1]); w.w = cvt_pk_bf16(x1[2], x1[3]);
            *(u32x4*)(mixed + (size_t)t * D + e0) = w;
            w.x = cvt_pk_bf16(y0[0], y0[1]); w.y = cvt_pk_bf16(y0[2], y0[3]); w.z = cvt_pk_bf16(y1[0], y1[1]); w.w = cvt_pk_bf16(y1[2], y1[3]);
            *(u32x4*)(mixed + (size_t)t * D + 1024 + e0) = w; }
    }
}

__device__ __forceinline__ void row_store_fp8(const Row& r, unsigned char* p, int lane) {
#pragma unroll
    for (int j = 0; j < 4; ++j) { const f32x4 a = r.v[2 * j], b = r.v[2 * j + 1]; int w0 = 0, w1 = 0;
        w0 = __builtin_amdgcn_cvt_pk_fp8_f32(a[0], a[1], w0, false); w0 = __builtin_amdgcn_cvt_pk_fp8_f32(a[2], a[3], w0, true); w1 = __builtin_amdgcn_cvt_pk_fp8_f32(b[0], b[1], w1, false); w1 = __builtin_amdgcn_cvt_pk_fp8_f32(b[2], b[3], w1, true);
        u32x2 w; w.x = (unsigned)w0; w.y = (unsigned)w1; *(u32x2*)(p + 512 * j + 8 * lane) = w; }
}
__device__ __forceinline__ void ln_phase(Frame& F, const float* y, const float* g, const float* b, float* hout, bf16* hb, unsigned char* hb8) {
    const int lane = F.lane, gw = F.bid * NWAVES + F.wave, NGW = F.G * NWAVES;
    Row rg, rb; row_load_f32(rg, g, lane); row_load_f32(rb, b, lane);
    for (int t = gw; t < M; t += NGW) { Row r; row_load_f32(r, y + (size_t)t * D, lane); row_layernorm(r, rg, rb); row_store_f32(r, hout + (size_t)t * D, lane); if (hb) row_store_bf16(r, hb + (size_t)t * D, lane); if (hb8) row_store_fp8(r, hb8 + (size_t)t * D, lane); }
}

__device__ __forceinline__ void router_phase(Frame& F, const float* h, const float* wr_, const float* rbias, gu32* cnt, int* tok_e, int* tok_slot, float* tok_gate, int* row_tok, float* row_gate) {
    const int tid = F.tid, wid = F.wave, lane = F.lane, fr = lane & 15, fq = lane >> 4;
    LAS float* sc = (LAS float*)F.lds;
    LAS int* lcnt = (LAS int*)(F.lds + 17408);
    LAS int* gbase = (LAS int*)(F.lds + 17408 + 256);
    LAS int* ti_e = (LAS int*)(F.lds + 18432);
    LAS int* ti_ls = (LAS int*)(F.lds + 18432 + 2048);
    LAS float* ti_g = (LAS float*)(F.lds + 18432 + 4096);
    for (int i = F.bid * NWAVES * 64 + tid; i < NROWS; i += F.G * NWAVES * 64) { const bool sh = i >= RB_SHARED0 * 256; row_tok[i] = sh ? i - RB_SHARED0 * 256 : 0; row_gate[i] = sh ? 1.0f : 0.0f; }
    for (int grp = F.bid; grp < M / 64; grp += F.G) {
        if (tid < 64) lcnt[tid] = 0;
        {
            constexpr int RDEPTH = 4, NIT = 64;
            f32x4 acc[4];
#pragma unroll
            for (int n = 0; n < 4; ++n) acc[n] = (f32x4){0.f, 0.f, 0.f, 0.f};
            const int kh = wid >> 2, ws4 = wid & 3;
            const float* xrow = h + (size_t)(grp * 64 + ws4 * 16 + fr) * D + kh * 1024 + 4 * fq;
            const float* wb = wr_ + (size_t)(kh * 1024 + 4 * fq) * NE + 4 * fr;
            f32x4 ra[RDEPTH], rb[RDEPTH][4];
#pragma unroll
            for (int i = 0; i < RDEPTH; ++i) { ra[i] = *(const f32x4*)(xrow + 16 * i);
#pragma unroll
                for (int s = 0; s < 4; ++s) rb[i][s] = *(const f32x4*)(wb + (size_t)(16 * i + s) * NE); }
#pragma unroll 1
            for (int it = 0; it < NIT; it += RDEPTH) {
#pragma unroll
                for (int u = 0; u < RDEPTH; ++u) {
                    const f32x4 a = ra[u]; f32x4 bq[4];
#pragma unroll
                    for (int s = 0; s < 4; ++s) bq[s] = rb[u][s];
                    if (it + RDEPTH < NIT) { const int nx = it + RDEPTH + u; ra[u] = *(const f32x4*)(xrow + 16 * nx);
#pragma unroll
                        for (int s = 0; s < 4; ++s) rb[u][s] = *(const f32x4*)(wb + (size_t)(16 * nx + s) * NE); }
#pragma unroll
                    for (int s = 0; s < 4; ++s)
#pragma unroll
                        for (int n = 0; n < 4; ++n) acc[n] = __builtin_amdgcn_mfma_f32_16x16x4f32(a[s], bq[s][n], acc[n], 0, 0, 0);
                }
            }
            if (kh == 1) {
#pragma unroll
                for (int n = 0; n < 4; ++n)
#pragma unroll
                    for (int e = 0; e < 4; ++e) sc[(ws4 * 16 + 4 * fq + e) * 65 + 4 * fr + n] = acc[n][e];
            }
            __syncthreads();
            if (kh == 0) {
#pragma unroll
                for (int n = 0; n < 4; ++n)
#pragma unroll
                    for (int e = 0; e < 4; ++e) sc[(ws4 * 16 + 4 * fq + e) * 65 + 4 * fr + n] += acc[n][e];
            }
        }
        __syncthreads();
        const float bias = rbias[lane];
        for (int ti = 0; ti < 8; ++ti) {
            const int tl = wid * 8 + ti;
            const float logit = sc[tl * 65 + lane];
            const float score = 1.0f / (1.0f + __expf(-logit));
            const float selv = score + bias;
            float m1 = selv;
#pragma unroll
            for (int o = 1; o < 8; o <<= 1) m1 = fmaxf(m1, __shfl_xor(m1, o));
            int i1 = (selv == m1) ? lane : 64;
#pragma unroll
            for (int o = 1; o < 8; o <<= 1) { const int x = __shfl_xor(i1, o); i1 = x < i1 ? x : i1; }
            float m2 = (lane == i1) ? -__builtin_inff() : selv;
#pragma unroll
            for (int o = 1; o < 8; o <<= 1) m2 = fmaxf(m2, __shfl_xor(m2, o));
            const float gs = m1 + m2; const int gi = lane >> 3;
            int rg = 0;
#pragma unroll
            for (int j = 0; j < 8; ++j) { const float og = __shfl(gs, 8 * j); rg += ((og > gs) || (og == gs && j < gi)) ? 1 : 0; }
            const bool gsel = rg < 4;
            const float mv = gsel ? selv : -__builtin_inff();
            int rk = 0;
#pragma unroll 4
            for (int j = 0; j < 64; ++j) { const float ov = __shfl(mv, j); rk += ((ov > mv) || (ov == mv && j < lane)) ? 1 : 0; }
            const bool chosen = gsel && (rk < TOPK);
            const float ssum = wave_sum(chosen ? score : 0.0f);
            if (chosen) { const int ls = __hip_atomic_fetch_add(lcnt + lane, 1, __ATOMIC_RELAXED, __HIP_MEMORY_SCOPE_WORKGROUP); ti_e[tl * 8 + rk] = lane; ti_ls[tl * 8 + rk] = ls; ti_g[tl * 8 + rk] = score / ssum * 2.5f; }
        }
        __syncthreads();
        if (tid < 64) gbase[tid] = (int)__hip_atomic_fetch_add((unsigned*)(cnt + tid), (unsigned)lcnt[tid], RLX_AGENT);
        __syncthreads();
        { const int e = ti_e[tid]; const size_t gi = (size_t)grp * 512 + tid; tok_e[gi] = e; tok_slot[gi] = gbase[e] + ti_ls[tid]; tok_gate[gi] = ti_g[tid]; }
        __syncthreads();
    }
}

__device__ __forceinline__ void scatter_phase(Frame& F, const gu32* cnt, const int* tok_e, const int* tok_slot, const float* tok_gate, int* tok_pos, int* row_tok, float* row_gate, int* meta) {
    LAS int* pstart = (LAS int*)F.lds;
    if (F.tid == 0) { int acc = 0; for (int e = 0; e < NE; ++e) { pstart[e] = acc; const int c = (int)__hip_atomic_load(cnt + e, RLX_AGENT); acc += (c + 255) >> 8; } pstart[NE] = acc; }
    __syncthreads();
    if (F.bid == 0) {
        if (F.tid == 0) meta[0] = pstart[NE];
        if (F.tid < NE) { for (int b = pstart[F.tid]; b < pstart[F.tid + 1]; ++b) meta[16 + b] = F.tid; }
    }
    for (int i = F.bid * NWAVES * 64 + F.tid; i < M * TOPK; i += F.G * NWAVES * 64) {
        const int e = tok_e[i], pos = pstart[e] * 256 + tok_slot[i];
        row_tok[pos] = i >> 3; row_gate[pos] = tok_gate[i]; tok_pos[i] = pos;
    }
}

__device__ __forceinline__ void combine_phase(Frame& F, const float* hres, const bf16* yrows, const int* tok_pos, const float* g, const float* b, float* hout, bf16* hb) {
    const int lane = F.lane, gw = F.bid * NWAVES + F.wave, NGW = F.G * NWAVES;
    Row rg, rb; row_load_f32(rg, g, lane); row_load_f32(rb, b, lane);
    for (int t = gw; t < M; t += NGW) {
        Row r; row_load_f32(r, hres + (size_t)t * D, lane);
#pragma unroll
        for (int i = 0; i < 8; ++i) r.v[i] = r.v[i] * ALPHA;
        int pos[8];
#pragma unroll
        for (int k = 0; k < 8; ++k) pos[k] = tok_pos[(size_t)t * 8 + k];
#pragma unroll
        for (int k = 0; k < 8; ++k) row_add_bf16(r, yrows + (size_t)pos[k] * D, lane);
        row_add_bf16(r, yrows + (size_t)(RB_SHARED0 * 256 + t) * D, lane);
        row_layernorm(r, rg, rb);
        row_store_f32(r, hout + (size_t)t * D, lane); if (hb) row_store_bf16(r, hb + (size_t)t * D, lane);
    }
}

constexpr int NPH_LAYER = 16, NPH = 2 + DEPTH * NPH_LAYER;
constexpr size_t SZ_WIN = (size_t)D * INW, SZ_DD = (size_t)D * D, SZ_EXP = (size_t)D * DE;

__global__ void __launch_bounds__(NWAVES * 64, 2) mk_fwd(Args args) {
    extern __shared__ __attribute__((aligned(16))) unsigned char lds_raw[];
    Frame F;
    F.lds = (lds_u8*)lds_raw; F.MISC = (volatile LAS unsigned*)(F.lds + MISC_OFF);
    F.tid = threadIdx.x; F.lane = F.tid & 63; F.wave = __builtin_amdgcn_readfirstlane(F.tid >> 6); F.G = gridDim.x; F.bid = blockIdx.x;
    F.ctl = (gu32*)(WSP + WS_CTL);
    if (F.tid < 64) F.MISC[F.tid] = 0u;
    __syncthreads();
    const int lo = args.ph_lo, hi = args.ph_hi;
    const bool use_bar = (hi - lo) > 1;
    XcdBarrier bar; bar.bar = (unsigned*)(F.ctl + CW_BAR); bar.x = 0; bar.st = nullptr;
    if (use_bar) bar = xcd_barrier_post((unsigned*)(F.ctl + CW_BAR), F.MISC + 8);
#define IN(k) (lo <= (k) && (k) < hi)
#ifndef MK_BAR_REP
#define MK_BAR_REP 1
#endif
#define SEAM(k) do { if (IN(k) && IN((k) + 1)) { for (int br_ = 0; br_ < MK_BAR_REP; ++br_) xcd_barrier(bar); } } while (0)

#define xin ((const float*)INP(0))
#define memb ((bf16*)(WSP + WS_MEMB))
#define Kc ((bf16*)(WSP + WS_KC))
#define VT ((bf16*)(WSP + WS_VT))
#define WinT ((bf16*)(WSP + WS_WIN))
#define WoutT ((bf16*)(WSP + WS_WOUT))
#define WqT ((bf16*)(WSP + WS_WQ))
#define WoT ((bf16*)(WSP + WS_WO))
#define WguT ((bf16*)(WSP + WS_WGU))
#define WdT ((bf16*)(WSP + WS_WD))
#define hbuf ((float*)(WSP + WS_H))
#define hb ((bf16*)(WSP + WS_HB))
#define ybuf ((float*)(WSP + WS_Y))
#define proj ((bf16*)(WSP + WS_PROJ))
#define oA ((bf16*)(WSP + WS_OA))
#define oB ((bf16*)(WSP + WS_OB))
#define lseB ((float*)(WSP + WS_LSE))
#define mixed ((bf16*)(WSP + WS_MIXED))
#define qb ((bf16*)(WSP + WS_Q))
#define Pb ((bf16*)(WSP + WS_P))
#define ob ((bf16*)(WSP + WS_O))
#define WkT ((bf16*)(WSP + WS_WKT))
#define WvT ((bf16*)(WSP + WS_WVT))
#define hid ((bf16*)(WSP + WS_HID))
#define yrows ((bf16*)(WSP + WS_YROWS))
#define meta ((int*)(WSP + WS_META))
#define tok_e ((int*)(WSP + WS_TOKE))
#define tok_slot ((int*)(WSP + WS_TOKSLOT))
#define tok_gate ((float*)(WSP + WS_TOKGATE))
#define tok_pos ((int*)(WSP + WS_TOKPOS))
#define row_tok ((int*)(WSP + WS_ROWTOK))
#define row_gate ((float*)(WSP + WS_ROWGATE))

    if (KIND_EN(0) && IN(0)) for (int rep = 0; rep < NREP(0); ++rep) { relaunder(F);
        const int gw = F.bid * NWAVES + F.wave, NGW = F.G * NWAVES; LAS float* scr = (LAS float*)(F.lds + F.wave * 16640);
        { const float* xp = xin; bf16* hbp = hb;
        for (size_t i = (size_t)F.bid * NWAVES * 64 + F.tid; i < (size_t)M * D / 8; i += (size_t)F.G * NWAVES * 64) {
            const f32x4 a = *(const f32x4*)(xp + i * 8), b = *(const f32x4*)(xp + i * 8 + 4);
            u32x4 w; w.x = cvt_pk_bf16(a[0], a[1]); w.y = cvt_pk_bf16(a[2], a[3]); w.z = cvt_pk_bf16(b[0], b[1]); w.w = cvt_pk_bf16(b[2], b[3]); *(u32x4*)(hbp + i * 8) = w; } }
        { const float* mem = INP(1); bf16* mb = memb;
        for (size_t i = (size_t)F.bid * NWAVES * 64 + F.tid; i < (size_t)NBATCH * 256 * D / 8; i += (size_t)F.G * NWAVES * 64) {
            const f32x4 a = *(const f32x4*)(mem + i * 8), b = *(const f32x4*)(mem + i * 8 + 4);
            u32x4 w; w.x = cvt_pk_bf16(a[0], a[1]); w.y = cvt_pk_bf16(a[2], a[3]); w.z = cvt_pk_bf16(b[0], b[1]); w.w = cvt_pk_bf16(b[2], b[3]); *(u32x4*)(mb + i * 8) = w; } }
        { const float* wk = INP(10); const float* wv = INP(11); bf16* wkt = WkT; bf16* wvt = WvT;
        for (int it = gw; it < 4096; it += NGW) { const int mat = it >> 10, sub = it & 1023, l = mat & 1;
            const float* W = (mat < 2 ? wk : wv) + (size_t)l * SZ_DD;
            tr_matrix_item<false>(W, D, D, mat < 2 ? wkt : wvt, (size_t)l * D, sub, scr, F.lane); } }
    }
    SEAM(0);
    if (KIND_EN(1) && IN(1)) for (int rep = 0; rep < NREP(1); ++rep) { relaunder(F);
        { pg8::ProbStatic P{(const char*)memb, (const char*)WkT, D, D, D, (size_t)256 * D * 2, 0, 0, (size_t)256 * D * 2, 0, 1, {}}; P.S.init(4, 16, F.G, F.bid);
          pg8::EpiBf16 E{Kc, 2 * D, 1.0f}; pg8::gemm_phase<pg8::EpiBf16, pg8::ProbStatic, false>(F.lds, P, E, F.tid); }
        { pg8::ProbStatic P{(const char*)WvT, (const char*)memb, D, D, D, (size_t)256 * D * 2, 0, 0, (size_t)256 * D * 2, 0, 1, {}}; P.S.init(16, 4, F.G, (F.bid + F.G / 2) % F.G);
          pg8::EpiBf16 E{VT, 1024, 1.0f}; pg8::gemm_phase<pg8::EpiBf16, pg8::ProbStatic, false>(F.lds, P, E, F.tid); }
    }
    SEAM(1);

    for (int l = 0; l < DEPTH; ++l) {
        const int pb = 2 + NPH_LAYER * l;
        const float* hres = (l == 0) ? xin : hbuf;
        if (KIND_EN(2) && IN(pb + 0)) for (int rep = 0; rep < NREP(2); ++rep) { relaunder(F);
            const int gw = F.bid * NWAVES + F.wave, NGW = F.G * NWAVES; LAS float* scr = (LAS float*)(F.lds + F.wave * 16640);
            const float* w_in = INP(2) + (size_t)l * SZ_WIN; const float* w_out = INP(6) + (size_t)l * SZ_DD;
            const float* wq = INP(9) + (size_t)l * SZ_DD; const float* wo = INP(12) + (size_t)l * SZ_DD;
            const float* wg = INP(17) + (size_t)l * NE * SZ_EXP; const float* wu = INP(18) + (size_t)l * NE * SZ_EXP; const float* wd = INP(19) + (size_t)l * NE * SZ_EXP;
            const float* wsg = INP(20) + (size_t)l * SZ_EXP; const float* wsu = INP(21) + (size_t)l * SZ_EXP; const float* wsd = INP(22) + (size_t)l * SZ_EXP;
            bf16* pWin = WinT; bf16* pWout = WoutT; bf16* pWq = WqT; bf16* pWo = WoT; bf16* pWgu = WguT; bf16* pWd = WdT;
            constexpr int I_IN = 32 * 68, I_DD = 1024, I_E = 256, NIT = I_IN + 3 * I_DD + 3 * 65 * I_E;
            for (int it = gw; it < NIT; it += NGW) {
                int r = it;
                if (r < I_IN) { tr_matrix_item<false>(w_in, D, INW, pWin, 0, r, scr, F.lane); continue; } r -= I_IN;
                if (r < I_DD) { tr_matrix_item<false>(w_out, D, D, pWout, 0, r, scr, F.lane); continue; } r -= I_DD;
                if (r < I_DD) { tr_matrix_item<false>(wq, D, D, pWq, 0, r, scr, F.lane); continue; } r -= I_DD;
                if (r < I_DD) { tr_matrix_item<false>(wo, D, D, pWo, 0, r, scr, F.lane); continue; } r -= I_DD;
                if (r < 65 * I_E) { const int e = r >> 8; tr_matrix_item8<true>(e < NE ? wg + (size_t)e * SZ_EXP : wsg, D, DE, (unsigned char*)pWgu + (size_t)e * 1024 * D, 0, r & 255, scr, F.lane, 64.0f); continue; } r -= 65 * I_E;
                if (r < 65 * I_E) { const int e = r >> 8; tr_matrix_item8<true>(e < NE ? wu + (size_t)e * SZ_EXP : wsu, D, DE, (unsigned char*)pWgu + (size_t)e * 1024 * D, 128, r & 255, scr, F.lane, 64.0f); continue; } r -= 65 * I_E;
                { const int e = r >> 8; tr_matrix_item8<false>(e < NE ? wd + (size_t)e * SZ_EXP : wsd, DE, D, (unsigned char*)pWd + (size_t)e * D * DE, 0, r & 255, scr, F.lane, 64.0f); }
            }
        }
        SEAM(pb + 0);
        if (KIND_EN(3) && IN(pb + 1)) for (int rep = 0; rep < NREP(3); ++rep) { relaunder(F);
            pg8::ProbStatic P{(const char*)hb, (const char*)WinT, D, D, D, (size_t)256 * D * 2, 0, 0, (size_t)256 * D * 2, 0, 1, {}}; P.S.init(M / 256, INW / 256, F.G, F.bid);
            pg8::EpiBf16 E{proj, INW, 1.0f}; pg8::gemm_phase<pg8::EpiBf16, pg8::ProbStatic, true>(F.lds, P, E, F.tid);
        }
        SEAM(pb + 1);
        if (KIND_EN(4) && IN(pb + 2)) for (int rep = 0; rep < NREP(4); ++rep) { relaunder(F); attn_phase(F, proj, INP(3) + l * 16, oA, oB, lseB); }
        SEAM(pb + 2);
        if (KIND_EN(5) && IN(pb + 3)) for (int rep = 0; rep < NREP(5); ++rep) { relaunder(F); merge_phase(F, oA, oB, lseB, INP(4) + l * 1024, INP(5) + l * 1024, mixed); }
        SEAM(pb + 3);
        if (KIND_EN(6) && IN(pb + 4)) for (int rep = 0; rep < NREP(6); ++rep) { relaunder(F);
            pg8::ProbStatic P{(const char*)mixed, (const char*)WoutT, D, D, D, (size_t)256 * D * 2, 0, 0, (size_t)256 * D * 2, 0, 1, {}}; P.S.init(M / 256, D / 256, F.G, F.bid);
            pg8::EpiResF32 E{hres, ybuf, D, ALPHA}; pg8::gemm_phase<pg8::EpiResF32, pg8::ProbStatic, true>(F.lds, P, E, F.tid);
        }
        SEAM(pb + 4);
        if (KIND_EN(7) && IN(pb + 5)) for (int rep = 0; rep < NREP(7); ++rep) { relaunder(F); ln_phase(F, ybuf, INP(7) + l * D, INP(8) + l * D, hbuf, hb, nullptr); }
        SEAM(pb + 5);
        if (KIND_EN(8) && IN(pb + 6)) for (int rep = 0; rep < NREP(8); ++rep) { relaunder(F);
            pg8::ProbStatic P{(const char*)hb, (const char*)WqT, D, D, D, (size_t)256 * D * 2, 0, 0, (size_t)256 * D * 2, 0, 1, {}}; P.S.init(M / 256, D / 256, F.G, F.bid);
            pg8::EpiBf16 E{qb, D, 1.0f}; pg8::gemm_phase<pg8::EpiBf16, pg8::ProbStatic, true>(F.lds, P, E, F.tid);
        }
        SEAM(pb + 6);
        if (KIND_EN(9) && IN(pb + 7)) for (int rep = 0; rep < NREP(9); ++rep) { relaunder(F);
            pg8::ProbStatic P{(const char*)qb, (const char*)(Kc + (size_t)l * D), D, 2 * D, 512, (size_t)256 * D * 2, (size_t)512 * 2, 0, (size_t)512 * 2, (size_t)256 * 2 * D * 2, 16, {}}; P.S.init(M / 256, 4, F.G, F.bid);
            pg8::EpiSoftmax E{Pb, 1024, 0.044194173824159216f * LOG2E}; pg8::gemm_phase<pg8::EpiSoftmax, pg8::ProbStatic, false>(F.lds, P, E, F.tid);
        }
        SEAM(pb + 7);
        if (KIND_EN(10) && IN(pb + 8)) for (int rep = 0; rep < NREP(10); ++rep) { relaunder(F);
            pg8::ProbStatic P{(const char*)Pb, (const char*)(VT + (size_t)l * D * 1024), 1024, 1024, 256, (size_t)256 * 1024 * 2, (size_t)256 * 2, 1, (size_t)256 * 1024 * 2, (size_t)256 * 2, 16, {}}; P.S.init(M / 256, 8, F.G, F.bid);
            pg8::EpiBf16 E{ob, D, 1.0f}; pg8::gemm_phase<pg8::EpiBf16, pg8::ProbStatic, true>(F.lds, P, E, F.tid);
        }
        SEAM(pb + 8);
        if (KIND_EN(11) && IN(pb + 9)) for (int rep = 0; rep < NREP(11); ++rep) { relaunder(F);
            pg8::ProbStatic P{(const char*)ob, (const char*)WoT, D, D, D, (size_t)256 * D * 2, 0, 0, (size_t)256 * D * 2, 0, 1, {}}; P.S.init(M / 256, D / 256, F.G, F.bid);
            pg8::EpiResF32 E{hbuf, ybuf, D, ALPHA}; pg8::gemm_phase<pg8::EpiResF32, pg8::ProbStatic, true>(F.lds, P, E, F.tid);
        }
        SEAM(pb + 9);
        if (KIND_EN(12) && IN(pb + 10)) for (int rep = 0; rep < NREP(12); ++rep) { relaunder(F); ln_phase(F, ybuf, INP(13) + l * D, INP(14) + l * D, hbuf, nullptr, (unsigned char*)hb); }
        SEAM(pb + 10);
        if (KIND_EN(13) && IN(pb + 11)) for (int rep = 0; rep < NREP(13); ++rep) { relaunder(F); router_phase(F, hbuf, INP(15) + (size_t)l * D * NE, INP(16) + l * NE, F.ctl + CW_CNT + ((rep + 1 < NREP(13)) ? 1024 : 0) + l * 64, tok_e, tok_slot, tok_gate, row_tok, row_gate); }
        SEAM(pb + 11);
        if (KIND_EN(14) && IN(pb + 12)) { relaunder(F); scatter_phase(F, F.ctl + CW_CNT + l * 64, tok_e, tok_slot, tok_gate, tok_pos, row_tok, row_gate, meta); }
        SEAM(pb + 12);
        if (KIND_EN(15) && IN(pb + 13)) for (int rep = 0; rep < NREP(15); ++rep) { relaunder(F);
            LAS int* blkexp = (LAS int*)(F.lds + BLKEXP_OFF); LAS int* tokbuf = (LAS int*)(F.lds + TOKBUF_OFF); LAS float* gatebuf = (LAS float*)(F.lds + GATEBUF_OFF);
            const int nblk = meta[0];
            for (int i = F.tid; i < 640; i += NWAVES * 64) blkexp[i] = (i < nblk) ? meta[16 + i] : NE;
            __syncthreads();
            const int ntot = (nblk + 64) * 4;
            pg8::ProbMoe<true> P{(const char*)hb, (const char*)WguT, D / 2, D / 2, D / 2, 4, (size_t)1024 * D, (size_t)256 * D, blkexp, tokbuf, nblk, ntot, (ntot + 7) / 8, F.bid & 7, F.bid >> 3, F.G >> 3};
            for (int i = 0; i < MAXORD; ++i) { pg8::Unit u; if (!P.next(i, u)) break;
                if (F.tid < 256) tokbuf[i * 256 + F.tid] = row_tok[u.pm * 256 + F.tid]; else gatebuf[i * 256 + F.tid - 256] = row_gate[u.pm * 256 + F.tid - 256]; }
            __syncthreads();
            pg8::EpiSwiGLU8 E{(unsigned char*)hid, gatebuf}; pg8::gemm_phase<pg8::EpiSwiGLU8, pg8::ProbMoe<true>, true, true>(F.lds, P, E, F.tid);
        }
        SEAM(pb + 13);
        if (KIND_EN(16) && IN(pb + 14)) for (int rep = 0; rep < NREP(16); ++rep) { relaunder(F);
            LAS int* blkexp = (LAS int*)(F.lds + BLKEXP_OFF);
            const int nblk = meta[0];
            for (int i = F.tid; i < 640; i += NWAVES * 64) blkexp[i] = (i < nblk) ? meta[16 + i] : NE;
            __syncthreads();
            const int ntot = (nblk + 64) * 8;
            pg8::ProbMoe<false> P{(const char*)hid, (const char*)WdT, DE / 2, DE / 2, DE / 2, 8, (size_t)D * DE, (size_t)256 * DE, blkexp, nullptr, nblk, ntot, (ntot + 7) / 8, F.bid & 7, F.bid >> 3, F.G >> 3};
            pg8::EpiBf16 E{yrows, D, 0.0009765625f}; pg8::gemm_phase<pg8::EpiBf16, pg8::ProbMoe<false>, true, true>(F.lds, P, E, F.tid);
        }
        SEAM(pb + 14);
        if (KIND_EN(17) && IN(pb + 15)) for (int rep = 0; rep < NREP(17); ++rep) { relaunder(F); combine_phase(F, hbuf, yrows, tok_pos, INP(23) + l * D, INP(24) + l * D, (rep + 1 < NREP(17)) ? ybuf : ((l == DEPTH - 1) ? OUTP : hbuf), (l == DEPTH - 1) ? nullptr : hb); }
        if (l + 1 < DEPTH) SEAM(pb + 15);
    }
    if (use_bar && hi == NPH) {
        if (__hip_atomic_load(F.ctl + CW_BAR + XB_TMO, RLX_AGENT) != 0u && F.tid == 0) { VM_WAIT(); OUTP[(size_t)F.bid * D] = __builtin_nanf(""); }
    }
#undef IN
#undef SEAM
}

extern "C" void kernel_launch(void* const* d_in, const int* in_sizes, int n_in, void* d_out, int out_size, void* d_ws, size_t ws_size, hipStream_t stream) {
    static int grid = 0;
    if (grid == 0) {
        if (n_in != 25 || in_sizes[0] != M * D || out_size != M * D || ws_size < WS_END) { fprintf(stderr, "kernel_launch: unexpected shapes (n_in %d, in0 %d, out %d, ws %zu, need %zu); nothing launched\n", n_in, n_in > 0 ? in_sizes[0] : -1, out_size, ws_size, (size_t)WS_END); grid = -1; return; }
        int dev = 0, cus = 0, per_cu = 0;
        if (hipGetDevice(&dev) != hipSuccess || hipDeviceGetAttribute(&cus, hipDeviceAttributeMultiprocessorCount, dev) != hipSuccess) { grid = -1; return; }
        if (hipFuncSetAttribute((const void*)mk_fwd, hipFuncAttributeMaxDynamicSharedMemorySize, LDS_BYTES) != hipSuccess) { fprintf(stderr, "kernel_launch: hipFuncSetAttribute failed\n"); grid = -1; return; }
        if (hipOccupancyMaxActiveBlocksPerMultiprocessor(&per_cu, (const void*)mk_fwd, NWAVES * 64, LDS_BYTES) != hipSuccess || per_cu < 1) fprintf(stderr, "kernel_launch: occupancy query reports %d\n", per_cu);
        (void)hipGetLastError();
        grid = cus;
        if (grid != 256) { fprintf(stderr, "kernel_launch: built for 256 CUs, device has %d; nothing launched\n", cus); grid = -1; return; }
    }
    if (grid < 0) return;
    if (hipMemsetAsync((char*)d_ws + WS_CTL, 0, CTL_ZERO_BYTES, stream) != hipSuccess) return;
    Args a{};
    for (int i = 0; i < 25; ++i) a.in[i] = (const float*)d_in[i];
    a.out = (float*)d_out; a.ws = (unsigned char*)d_ws;
#if MK_N_LAUNCHES == 1
    a.ph_lo = 0; a.ph_hi = NPH;
    hipLaunchKernelGGL(mk_fwd, dim3(grid), dim3(NWAVES * 64), LDS_BYTES, stream, a);
#else
    for (int p = 0; p < NPH; ++p) { a.ph_lo = p; a.ph_hi = p + 1; hipLaunchKernelGGL(mk_fwd, dim3(grid), dim3(NWAVES * 64), LDS_BYTES, stream, a); }
#endif
}
```

```cpp
#include <hip/hip_runtime.h>
#include <cstdio>
#include <cstdint>

#ifndef MK_N_LAUNCHES
#define MK_N_LAUNCHES 1
#endif
#ifndef MK_KINDS
#define MK_KINDS 0x3ffff
#endif
#define KIND_EN(k) (((MK_KINDS) >> (k)) & 1)
#ifndef MK_REP_MASK
#define MK_REP_MASK 0
#endif
#define NREP(k) (1 + (((MK_REP_MASK) >> (k)) & 1))

#define GAS __attribute__((address_space(1)))
#define LAS __attribute__((address_space(3)))
typedef unsigned short bf16;
typedef short bf16x8 __attribute__((ext_vector_type(8)));
typedef short s16x4 __attribute__((ext_vector_type(4)));
typedef float f32x4 __attribute__((ext_vector_type(4)));
typedef float f32x2 __attribute__((ext_vector_type(2)));
typedef unsigned u32x4 __attribute__((ext_vector_type(4)));
typedef unsigned u32x2 __attribute__((ext_vector_type(2)));
typedef int i32x8 __attribute__((ext_vector_type(8)));
typedef int i32x4 __attribute__((ext_vector_type(4)));
typedef LAS unsigned char lds_u8;
typedef GAS unsigned gu32;

constexpr int D = 2048, NBATCH = 4, SEQ = 4096, M = NBATCH * SEQ, DEPTH = 2;
constexpr int INW = 4352;
constexpr int NE = 64, TOPK = 8, DE = 512;
constexpr float ALPHA = 1.4142135623730951f;
constexpr float LN_EPS = 1e-5f, RMS_EPS = 1e-6f;
constexpr float LOG2E = 1.4426950408889634f;
constexpr int RB_SHARED0 = 576;
constexpr int NROWS = (RB_SHARED0 + 64) * 256;
constexpr int MAXORD = 12;

constexpr size_t MiB = 1u << 20;
constexpr size_t WS_CTL = 0, CTL_ZERO_BYTES = 1 * MiB;
constexpr size_t WS_META = 1 * MiB;
constexpr size_t WS_TOKE = 2 * MiB, WS_TOKSLOT = 2 * MiB + 512 * 1024, WS_TOKGATE = 3 * MiB, WS_TOKPOS = 3 * MiB + 512 * 1024;
constexpr size_t WS_ROWTOK = 4 * MiB, WS_ROWGATE = 5 * MiB;
constexpr size_t WS_MEMB = 6 * MiB, WS_KC = 10 * MiB, WS_VT = 18 * MiB;
constexpr size_t WS_WIN = 26 * MiB, WS_WOUT = 43 * MiB, WS_WQ = 51 * MiB, WS_WO = 59 * MiB, WS_WGU = 67 * MiB, WS_WD = 327 * MiB;
constexpr size_t WS_H = 457 * MiB, WS_HB = 585 * MiB, WS_Y = 649 * MiB, WS_R = 777 * MiB;
constexpr size_t WS_PROJ = WS_R, WS_OA = WS_R + 136 * MiB, WS_OB = WS_R + 168 * MiB, WS_LSE = WS_R + 264 * MiB, WS_MIXED = WS_R + 267 * MiB;
constexpr size_t WS_Q = WS_R + 331 * MiB, WS_P = WS_R + 395 * MiB, WS_O = WS_R + 427 * MiB;
constexpr size_t WS_WKT = WS_R, WS_WVT = WS_R + 16 * MiB;
constexpr size_t WS_HID = WS_R, WS_YROWS = WS_R + 160 * MiB;
constexpr size_t WS_END = WS_R + 800 * MiB;
constexpr int CW_TMO = 0, CW_CODE = 1;
constexpr int CW_BAR = 4096;
constexpr int CW_CNT = 16384;

constexpr int RING_BYTES = 131072;
constexpr int AUX_OFF = RING_BYTES;
constexpr int TOKBUF_OFF = AUX_OFF, GATEBUF_OFF = AUX_OFF + MAXORD * 1024, BLKEXP_OFF = GATEBUF_OFF + MAXORD * 1024;
constexpr int MISC_OFF = BLKEXP_OFF + 2560;
constexpr int LDS_BYTES = MISC_OFF + 256;
static_assert(LDS_BYTES <= 160 * 1024 && (MISC_OFF % 16) == 0, "LDS map");

#define RLX_AGENT __ATOMIC_RELAXED, __HIP_MEMORY_SCOPE_AGENT
#define LDS_WAIT() asm volatile("s_waitcnt lgkmcnt(0)" ::: "memory")
#define VM_WAIT() asm volatile("s_waitcnt vmcnt(0)" ::: "memory")
__device__ __forceinline__ unsigned cvt_pk_bf16(float lo, float hi) { unsigned r; asm volatile("v_cvt_pk_bf16_f32 %0, %1, %2" : "=v"(r) : "v"(lo), "v"(hi)); return r; }
__device__ __forceinline__ float bf_lo(unsigned w) { return __uint_as_float(w << 16); }
__device__ __forceinline__ float bf_hi(unsigned w) { return __uint_as_float(w & 0xffff0000u); }
__device__ __forceinline__ float wave_sum(float v) {
#pragma unroll
    for (int o = 1; o < 64; o <<= 1) v += __shfl_xor(v, o);
    return v;
}

#define XB_TMO      128
#define XB_XCNT(j)  (256  + 64 * (j))
#define XB_XSUB(j)  (1280 + 64 * (j))
#define XB_XGEN(j)  (2304 + 64 * (j))
#define XB_TOP      3328
#define XB_TOPGEN   3392
#define XCD_BAR_WORDS 3456
#define XB_SPIN_CAP (1u << 18)
__device__ __forceinline__ unsigned xb_ld(unsigned* p)              { return __hip_atomic_load(p, __ATOMIC_RELAXED, __HIP_MEMORY_SCOPE_AGENT); }
__device__ __forceinline__ unsigned xb_add(unsigned* p, unsigned v) { return __hip_atomic_fetch_add(p, v, __ATOMIC_RELAXED, __HIP_MEMORY_SCOPE_AGENT); }
__device__ __forceinline__ unsigned xb_xcc_id() { return (unsigned)__builtin_amdgcn_s_getreg((3 << 11) | 20) & 0xFu; }
#define XB_SPIN(cond, bar) do { unsigned _sp = 0; while (cond) { __builtin_amdgcn_s_sleep(1); \
    if ((++_sp & 255u) == 0u) { if (xb_ld(&(bar)[XB_TMO])) break; if (_sp > XB_SPIN_CAP) { atomicAdd(&(bar)[XB_TMO], 1u); break; } } } } while (0)
struct XcdBarrier { unsigned* bar; unsigned x; volatile LAS unsigned* st; };
__device__ __forceinline__ XcdBarrier xcd_barrier_post(unsigned* bar, volatile LAS unsigned* st) {
    XcdBarrier b; b.bar = bar; b.x = xb_xcc_id(); b.st = st;
    if (threadIdx.x == 0) (void)xb_add(&bar[XB_XCNT(b.x)], 1u);
    return b;
}
__device__ __forceinline__ void xcd_barrier_complete(unsigned* bar, unsigned x, unsigned& nloc, unsigned& nx) {
    const unsigned G = gridDim.x * gridDim.y * gridDim.z;
    unsigned sum, cnt, mine, sp = 0u;
    for (;;) {
        sum = 0u; cnt = 0u; mine = 0u;
#pragma unroll
        for (unsigned j = 0; j < 16; ++j) { const unsigned c = xb_ld(&bar[XB_XCNT(j)]); sum += c; cnt += (c > 0u) ? 1u : 0u; mine = (j == x) ? c : mine; }
        if (sum == G) break;
        __builtin_amdgcn_s_sleep(1);
        if ((++sp & 255u) == 0u) { if (xb_ld(&bar[XB_TMO])) break; if (sp > XB_SPIN_CAP) { atomicAdd(&bar[XB_TMO], 1u); break; } }
    }
    nloc = mine > 0u ? mine : 1u; nx = cnt > 0u ? cnt : 1u;
}
__device__ __forceinline__ void xcd_barrier(const XcdBarrier& b) {
    asm volatile("s_waitcnt vmcnt(0)" ::: "memory");
    __syncthreads();
    if (threadIdx.x == 0) {
        unsigned* bar = b.bar;
        __builtin_amdgcn_s_waitcnt(0);
        unsigned nloc = b.st[0], nx = b.st[1];
        if (nloc == 0u) { xcd_barrier_complete(bar, b.x, nloc, nx); b.st[0] = nloc; b.st[1] = nx; }
        const unsigned old = xb_add(&bar[XB_XSUB(b.x)], 1u);
        const unsigned gen = old / nloc;
        if (old + 1u == (gen + 1u) * nloc) {
            __builtin_amdgcn_fence(__ATOMIC_RELEASE, "agent");
            asm volatile("s_waitcnt vmcnt(0)" ::: "memory");
            const unsigned og = xb_add(&bar[XB_TOP], 1u);
            const unsigned tg = og / nx;
            if (og + 1u == (tg + 1u) * nx) xb_add(&bar[XB_TOPGEN], 1u);
            else XB_SPIN(xb_ld(&bar[XB_TOPGEN]) == tg, bar);
            __builtin_amdgcn_fence(__ATOMIC_ACQUIRE, "agent");
            xb_add(&bar[XB_XGEN(b.x)], 1u);
            asm volatile("s_waitcnt vmcnt(0)" ::: "memory");
        } else {
            XB_SPIN(xb_ld(&bar[XB_XGEN(b.x)]) == gen, bar);
            __builtin_amdgcn_fence(__ATOMIC_ACQUIRE, "agent");
            asm volatile("s_waitcnt vmcnt(0)" ::: "memory");
        }
    }
    __syncthreads();
}

__device__ __forceinline__ void glds_saddr(unsigned voff, const char* sbase, unsigned lds_dst) { unsigned keep;
    asm volatile("s_mov_b32 %0, m0\n\ts_mov_b32 m0, %3\n\ts_nop 0\n\tglobal_load_lds_dwordx4 %1, %2\n\ts_mov_b32 m0, %0" : "=&s"(keep) : "v"(voff), "s"(sbase), "s"(lds_dst) : "memory"); }
namespace pg8 {
constexpr int BM = 256, BK = 64, HALF = 128, HTB = HALF * BK * 2, STAGE_BYTES = 8 * HTB, NXCD = 8, WGM = 8;
__host__ __device__ __forceinline__ int lds_byte(int r, int c) { const int st = (r >> 4) * 2 + (c >> 5), rr = r & 15, cc = c & 31, ob = rr * 64 + cc * 2; return st * 1024 + (ob ^ (((ob >> 9) & 1) << 5)); }
__host__ __device__ __forceinline__ void stage_rc(int b, int& R, int& C) { const int st = b / 1024, sb = b % 1024, swz = sb ^ (((sb >> 9) & 1) << 5); R = (st >> 1) * 16 + swz / 64; C = (st & 1) * 32 + (swz % 64) / 2; }
__host__ __device__ __forceinline__ int perm32(int rho) { const int n = rho >> 4, i = rho & 15; return 8 * (i >> 2) + 4 * n + (i & 3); }

struct Unit { int pm, pn, ex, ord; };

struct StaticOrder {
    int nM, nN, nwg, G, c;
    __device__ void init(int nM_, int nN_, int G_, int c_) { nM = nM_; nN = nN_; nwg = nM * nN; G = G_; c = c_; }
    __device__ bool next(int i, Unit& u) const {
        const long L = (long)i * G + c; if (L >= nwg) return false;
        int wgid = (int)L; { const int q = nwg / NXCD, r = nwg % NXCD, xcd = wgid % NXCD, off = wgid / NXCD; wgid = (xcd < r ? xcd * (q + 1) : r * (q + 1) + (xcd - r) * q) + off; }
        const int nig = WGM * nN, gid = wgid / nig, fm = gid * WGM, gsz = (nM - fm) < WGM ? (nM - fm) : WGM;
        u.pm = fm + ((wgid % nig) % gsz); u.pn = (wgid % nig) / gsz; u.ex = 0; u.ord = i; return true;
    }
};

struct ProbStatic {
    const char* A0; const char* B0; int lda, ldb, K;
    size_t a_pm_step, a_pn_step; int a_pn_shift; size_t b_pn_step, b_batch_step; int batch_div;
    StaticOrder S;
    __device__ __forceinline__ bool next(int i, Unit& u) const { return S.next(i, u); }
    __device__ __forceinline__ const char* a_base(const Unit& u) const { return A0 + (size_t)u.pm * a_pm_step + (size_t)(u.pn >> a_pn_shift) * a_pn_step; }
    __device__ __forceinline__ const char* b_base(const Unit& u) const { return B0 + (size_t)u.pn * b_pn_step + (size_t)(u.pm / batch_div) * b_batch_step; }
    __device__ __forceinline__ void a_offs(const Unit&, const int (&R)[2], const int (&C)[2], unsigned (&vo)[2][2]) const {
#pragma unroll
        for (int h = 0; h < 2; ++h)
#pragma unroll
            for (int i = 0; i < 2; ++i) vo[h][i] = (unsigned)((R[i] + HALF * h) * lda + C[i]) * 2u;
    }
};

template <bool GATHER> struct ProbMoe {
    const char* A0; const char* B0; int lda, ldb, K, npn; size_t b_e_step, b_pn_step;
    const LAS int* blkexp; const LAS int* tokbuf; int nblk, ntot, chunk, xcd, rank, nrank;
    __device__ __forceinline__ bool next(int i, Unit& u) const {
        const int idx = xcd * chunk + i * nrank + rank; int lim = (xcd + 1) * chunk; lim = lim < ntot ? lim : ntot;
        if (idx >= lim || i * nrank + rank >= chunk) return false;
        const int lb = idx / npn; u.pn = idx - lb * npn;
        if (lb < nblk) { u.pm = lb; u.ex = blkexp[lb]; } else { u.pm = RB_SHARED0 + (lb - nblk); u.ex = NE; }
        u.ord = i; return true;
    }
    __device__ __forceinline__ const char* a_base(const Unit& u) const { return GATHER ? A0 : A0 + (size_t)u.pm * BM * lda * 2; }
    __device__ __forceinline__ const char* b_base(const Unit& u) const { return B0 + (size_t)u.ex * b_e_step + (size_t)u.pn * b_pn_step; }
    __device__ __forceinline__ void a_offs(const Unit& u, const int (&R)[2], const int (&C)[2], unsigned (&vo)[2][2]) const {
#pragma unroll
        for (int h = 0; h < 2; ++h)
#pragma unroll
            for (int i = 0; i < 2; ++i) {
                if (GATHER) { const int tok = tokbuf[u.ord * 256 + R[i] + HALF * h]; vo[h][i] = (unsigned)(tok * lda + C[i]) * 2u; }
                else vo[h][i] = (unsigned)((R[i] + HALF * h) * lda + C[i]) * 2u;
            }
    }
};

struct EpiBf16 {
    static constexpr bool PERM = true, AFTER_DRAIN = false;
    bf16* O; int ldc; float scale;
    __device__ __forceinline__ void operator()(const f32x4 (&acc)[2][2][4][2], const Unit& u, int wr, int wc, int fr, int fq) const {
        const int row0 = u.pm * BM + wr * 64 + fr, col0 = u.pn * BM + wc * 32 + 8 * fq;
#pragma unroll
        for (int ai = 0; ai < 2; ++ai)
#pragma unroll
            for (int m = 0; m < 4; ++m) { bf16* rowp = O + (size_t)(row0 + ai * HALF + m * 16) * ldc + col0;
#pragma unroll
                for (int bj = 0; bj < 2; ++bj) { const f32x4 v0 = acc[ai][bj][m][0] * scale, v1 = acc[ai][bj][m][1] * scale;
                    u32x4 w; w.x = cvt_pk_bf16(v0[0], v0[1]); w.y = cvt_pk_bf16(v0[2], v0[3]); w.z = cvt_pk_bf16(v1[0], v1[1]); w.w = cvt_pk_bf16(v1[2], v1[3]);
                    *(u32x4*)(rowp + bj * HALF) = w; } }
    }
};
struct EpiFp8 {
    static constexpr bool PERM = true, AFTER_DRAIN = false;
    unsigned char* O; int ldc; float scale;
    __device__ __forceinline__ void operator()(const f32x4 (&acc)[2][2][4][2], const Unit& u, int wr, int wc, int fr, int fq) const {
        const int row0 = u.pm * BM + wr * 64 + fr, col0 = u.pn * BM + wc * 32 + 8 * fq;
#pragma unroll
        for (int ai = 0; ai < 2; ++ai)
#pragma unroll
            for (int m = 0; m < 4; ++m) { unsigned char* rowp = O + (size_t)(row0 + ai * HALF + m * 16) * ldc + col0;
#pragma unroll
                for (int bj = 0; bj < 2; ++bj) { const f32x4 v0 = acc[ai][bj][m][0] * scale, v1 = acc[ai][bj][m][1] * scale; int w0 = 0, w1 = 0;
                    w0 = __builtin_amdgcn_cvt_pk_fp8_f32(v0[0], v0[1], w0, false); w0 = __builtin_amdgcn_cvt_pk_fp8_f32(v0[2], v0[3], w0, true);
                    w1 = __builtin_amdgcn_cvt_pk_fp8_f32(v1[0], v1[1], w1, false); w1 = __builtin_amdgcn_cvt_pk_fp8_f32(v1[2], v1[3], w1, true);
                    u32x2 w; w.x = (unsigned)w0; w.y = (unsigned)w1; *(u32x2*)(rowp + bj * HALF) = w; } }
    }
};
struct EpiResF32 {
    static constexpr bool PERM = false, AFTER_DRAIN = false;
    const float* base; float* Y; int ldc; float alpha;
    __device__ __forceinline__ void operator()(const f32x4 (&acc)[2][2][4][2], const Unit& u, int wr, int wc, int fr, int fq) const {
        const int row0 = u.pm * BM + wr * 64 + fr, col0 = u.pn * BM + wc * 32 + 4 * fq;
#pragma unroll
        for (int ai = 0; ai < 2; ++ai)
#pragma unroll
            for (int m = 0; m < 4; ++m) { const size_t off = (size_t)(row0 + ai * HALF + m * 16) * ldc + col0;
#pragma unroll
                for (int bj = 0; bj < 2; ++bj)
#pragma unroll
                    for (int n = 0; n < 2; ++n) { const f32x4 b = *(const f32x4*)(base + off + bj * HALF + n * 16); *(f32x4*)(Y + off + bj * HALF + n * 16) = b * alpha + acc[ai][bj][m][n]; } }
    }
};
struct EpiSwiGLU {
    static constexpr bool PERM = true, AFTER_DRAIN = false;
    bf16* Hd; const LAS float* gatebuf;
    __device__ __forceinline__ void operator()(const f32x4 (&acc)[2][2][4][2], const Unit& u, int wr, int wc, int fr, int fq) const {
        const int r0 = wr * 64 + fr, col0 = u.pn * HALF + wc * 32 + 8 * fq;
#pragma unroll
        for (int ai = 0; ai < 2; ++ai)
#pragma unroll
            for (int m = 0; m < 4; ++m) { const int r = r0 + ai * HALF + m * 16; const float gt = gatebuf[u.ord * 256 + r];
                float o[8];
#pragma unroll
                for (int n = 0; n < 2; ++n)
#pragma unroll
                    for (int e = 0; e < 4; ++e) { const float g = acc[ai][0][m][n][e], up = acc[ai][1][m][n][e];
                        const float sg = g * __builtin_amdgcn_rcpf(1.0f + __builtin_amdgcn_exp2f(-g * LOG2E)); o[n * 4 + e] = sg * up * gt; }
                u32x4 w; w.x = cvt_pk_bf16(o[0], o[1]); w.y = cvt_pk_bf16(o[2], o[3]); w.z = cvt_pk_bf16(o[4], o[5]); w.w = cvt_pk_bf16(o[6], o[7]);
                *(u32x4*)(Hd + (size_t)(u.pm * BM + r) * DE + col0) = w; }
    }
};
struct EpiSwiGLU8 {
    static constexpr bool PERM = true, AFTER_DRAIN = false;
    unsigned char* Hd; const LAS float* gatebuf;
    __device__ __forceinline__ void operator()(const f32x4 (&acc)[2][2][4][2], const Unit& u, int wr, int wc, int fr, int fq) const {
        const int r0 = wr * 64 + fr, col0 = u.pn * HALF + wc * 32 + 8 * fq;
#pragma unroll
        for (int ai = 0; ai < 2; ++ai)
#pragma unroll
            for (int m = 0; m < 4; ++m) { const int r = r0 + ai * HALF + m * 16; const float gt = gatebuf[u.ord * 256 + r] * 16.0f;
                float o[8];
#pragma unroll
                for (int n = 0; n < 2; ++n)
#pragma unroll
                    for (int e = 0; e < 4; ++e) { const float g = acc[ai][0][m][n][e] * 0.015625f, up = acc[ai][1][m][n][e] * 0.015625f;
                        const float sg = g * __builtin_amdgcn_rcpf(1.0f + __builtin_amdgcn_exp2f(-g * LOG2E)); o[n * 4 + e] = sg * up * gt; }
                int w0 = 0, w1 = 0;
                w0 = __builtin_amdgcn_cvt_pk_fp8_f32(o[0], o[1], w0, false); w0 = __builtin_amdgcn_cvt_pk_fp8_f32(o[2], o[3], w0, true);
                w1 = __builtin_amdgcn_cvt_pk_fp8_f32(o[4], o[5], w1, false); w1 = __builtin_amdgcn_cvt_pk_fp8_f32(o[6], o[7], w1, true);
                u32x2 w; w.x = (unsigned)w0; w.y = (unsigned)w1;
                *(u32x2*)(Hd + (size_t)(u.pm * BM + r) * DE + col0) = w; }
    }
};
struct EpiSoftmax {
    static constexpr bool PERM = true, AFTER_DRAIN = true;
    bf16* O; int ldc; float scale2;
    __device__ __forceinline__ void operator()(const f32x4 (&)[2][2][4][2], const Unit&, int, int, int, int) const {}
    __device__ __forceinline__ void fused(f32x4 (&acc)[2][2][4][2], const Unit& u, int wr, int wc, int fr, int fq, lds_u8* lds, int wid, int lane) const {
        LAS float* X = (LAS float*)lds;
        LAS float* Z = (LAS float*)(lds + 4096);
        float mx[2][4];
#pragma unroll
        for (int ai = 0; ai < 2; ++ai)
#pragma unroll
            for (int m = 0; m < 4; ++m) { float v = -3.0e38f;
#pragma unroll
                for (int bj = 0; bj < 2; ++bj)
#pragma unroll
                    for (int n = 0; n < 2; ++n) { acc[ai][bj][m][n] = acc[ai][bj][m][n] * scale2; const f32x4 x = acc[ai][bj][m][n]; v = fmaxf(v, fmaxf(fmaxf(x[0], x[1]), fmaxf(x[2], x[3]))); }
                v = fmaxf(v, __shfl_xor(v, 16)); v = fmaxf(v, __shfl_xor(v, 32));
                if (fq == 0) X[(ai * HALF + wr * 64 + m * 16 + fr) * 4 + wc] = v; }
        asm volatile("s_waitcnt lgkmcnt(0)" ::: "memory"); __builtin_amdgcn_s_barrier(); asm volatile("" ::: "memory");
#pragma unroll
        for (int ai = 0; ai < 2; ++ai)
#pragma unroll
            for (int m = 0; m < 4; ++m) { const int r = ai * HALF + wr * 64 + m * 16 + fr; const f32x4 t = *(const LAS f32x4*)(X + r * 4);
                const float mm = fmaxf(fmaxf(t[0], t[1]), fmaxf(t[2], t[3])); mx[ai][m] = mm; float s = 0.f;
#pragma unroll
                for (int bj = 0; bj < 2; ++bj)
#pragma unroll
                    for (int n = 0; n < 2; ++n) { f32x4 x = acc[ai][bj][m][n];
#pragma unroll
                        for (int e = 0; e < 4; ++e) x[e] = __builtin_amdgcn_exp2f(x[e] - mm);
                        acc[ai][bj][m][n] = x; s += (x[0] + x[1]) + (x[2] + x[3]); }
                s += __shfl_xor(s, 16); s += __shfl_xor(s, 32);
                if (fq == 0) Z[r * 4 + wc] = s; }
        asm volatile("s_waitcnt lgkmcnt(0)" ::: "memory"); __builtin_amdgcn_s_barrier(); asm volatile("" ::: "memory");
        const int row0 = u.pm * BM + wr * 64 + fr, col0 = u.pn * BM + wc * 32 + 8 * fq;
#pragma unroll
        for (int ai = 0; ai < 2; ++ai)
#pragma unroll
            for (int m = 0; m < 4; ++m) { const int r = ai * HALF + wr * 64 + m * 16 + fr; const f32x4 t = *(const LAS f32x4*)(Z + r * 4);
                const float inv = 1.0f / ((t[0] + t[1]) + (t[2] + t[3]));
                bf16* rowp = O + (size_t)(row0 + ai * HALF + m * 16) * ldc + col0;
#pragma unroll
                for (int bj = 0; bj < 2; ++bj) { const f32x4 v0 = acc[ai][bj][m][0] * inv, v1 = acc[ai][bj][m][1] * inv;
                    u32x4 w; w.x = cvt_pk_bf16(v0[0], v0[1]); w.y = cvt_pk_bf16(v0[2], v0[3]); w.z = cvt_pk_bf16(v1[0], v1[1]); w.w = cvt_pk_bf16(v1[2], v1[3]);
                    *(u32x4*)(rowp + bj * HALF) = w; } }
        (void)mx; (void)wid; (void)lane;
    }
};

template <class Epi, class Prob, bool ALIGN_EPI, bool FP8 = false>
__device__ __forceinline__ void gemm_phase(lds_u8* lds, const Prob& P, const Epi& E, const int tid) {
    const int wid = __builtin_amdgcn_readfirstlane(tid >> 6), lane = tid & 63, wr = wid >> 2, wc = wid & 3, fr = lane & 15, fq = lane >> 4;
    const int nt = P.K / BK;
    int Rr[2], Cc[2]; unsigned voffB[2];
#pragma unroll
    for (int i = 0; i < 2; ++i) { stage_rc(tid * 16 + i * 8192, Rr[i], Cc[i]); const int Rb = Epi::PERM ? ((Rr[i] & ~31) + perm32(Rr[i] & 31)) : Rr[i];
        voffB[i] = (unsigned)(Rb * P.ldb + Cc[i]) * 2u; }
    const size_t kstep = (size_t)(BK * 2);
    const size_t hstepB = (size_t)HALF * P.ldb * 2;
    const unsigned ldsw = (unsigned)wid * 1024u;
    const unsigned ldsb = (unsigned)__builtin_amdgcn_readfirstlane((int)(unsigned)(size_t)lds);
    const int aoff = lds_byte(wr * 64 + fr, fq * 8), boff = lds_byte(wc * 32 + fr, fq * 8);
#define PG8_SA(b, h) (((b) * 2 + (h)) * HTB)
#define PG8_SB(b, h) ((4 + (b) * 2 + (h)) * HTB)
#define PG8_STAGE(bufoff, gbase, voff) do { _Pragma("unroll") for (int _i = 0; _i < 2; ++_i) \
        glds_saddr((voff)[_i], (const char*)(gbase), ldsb + (unsigned)(bufoff) + ldsw + (unsigned)(_i * 8192)); } while (0)
#define PG8_LDA(dst, b, h) do { _Pragma("unroll") for (int m = 0; m < 4; ++m) _Pragma("unroll") for (int k = 0; k < 2; ++k) dst[m][k] = *(const LAS bf16x8*)(lds + PG8_SA(b, h) + aoff + m * 2048 + k * 1024); } while (0)
#define PG8_LDB(dst, b, h) do { _Pragma("unroll") for (int n = 0; n < 2; ++n) _Pragma("unroll") for (int k = 0; k < 2; ++k) dst[n][k] = *(const LAS bf16x8*)(lds + PG8_SB(b, h) + boff + n * 2048 + k * 1024); } while (0)
#define PG8_CAT(x0, x1) __builtin_shufflevector(__builtin_bit_cast(i32x4, x0), __builtin_bit_cast(i32x4, x1), 0, 1, 2, 3, 4, 5, 6, 7)
#define PG8_MMA(ai, bj, At, Bt) do { __builtin_amdgcn_s_setprio(1); \
        if constexpr (FP8) { _Pragma("unroll") for (int m = 0; m < 4; ++m) _Pragma("unroll") for (int n = 0; n < 2; ++n) \
            asm volatile("v_mfma_scale_f32_16x16x128_f8f6f4 %0, %1, %2, %0, %3, %3 op_sel_hi:[0,0,0]" : "+v"(acc[ai][bj][m][n]) : "v"(PG8_CAT(Bt[n][0], Bt[n][1])), "v"(PG8_CAT(At[m][0], At[m][1])), "v"(0x7f7f7f7f)); } \
        else { _Pragma("unroll") for (int m = 0; m < 4; ++m) _Pragma("unroll") for (int n = 0; n < 2; ++n) _Pragma("unroll") for (int k = 0; k < 2; ++k) \
            acc[ai][bj][m][n] = __builtin_amdgcn_mfma_f32_16x16x32_bf16(Bt[n][k], At[m][k], acc[ai][bj][m][n], 0, 0, 0); } \
        __builtin_amdgcn_s_setprio(0); } while (0)
#define PG8_WAIT_V(n) asm volatile("s_waitcnt vmcnt(" #n ")" ::: "memory")
#define PG8_WAIT_L(n) asm volatile("s_waitcnt lgkmcnt(" #n ")" ::: "memory")
#define PG8_BAR __builtin_amdgcn_s_barrier()
#define PG8_SCHED __builtin_amdgcn_sched_barrier(0)
    Unit cur, nxt; int ui = 0;
    if (!P.next(0, cur)) return;
    f32x4 acc[2][2][4][2];
#pragma unroll
    for (int a = 0; a < 2; ++a)
#pragma unroll
        for (int b = 0; b < 2; ++b)
#pragma unroll
            for (int m = 0; m < 4; ++m)
#pragma unroll
                for (int n = 0; n < 2; ++n) acc[a][b][m][n] = (f32x4){0.f, 0.f, 0.f, 0.f};
    bf16x8 At[4][2], B0[2][2], B1[2][2];
    unsigned vA[2][2], nvA[2][2];
    P.a_offs(cur, Rr, Cc, vA);
    const char* cA = P.a_base(cur); const char* cB = P.b_base(cur);
    PG8_STAGE(PG8_SB(0, 0), cB, voffB); PG8_STAGE(PG8_SB(0, 1), cB + hstepB, voffB); PG8_STAGE(PG8_SA(0, 0), cA, vA[0]); PG8_STAGE(PG8_SA(0, 1), cA, vA[1]);
    if (wr == 1) PG8_BAR;
    PG8_WAIT_V(2); PG8_BAR;
    PG8_STAGE(PG8_SB(1, 0), cB + kstep, voffB); PG8_STAGE(PG8_SA(1, 0), cA + kstep, vA[0]); PG8_STAGE(PG8_SB(1, 1), cB + hstepB + kstep, voffB);
    PG8_WAIT_V(6); PG8_BAR;
    for (;;) {
        const bool has_next = P.next(ui + 1, nxt);
        const char* nA = cA; const char* nB = cB;
#pragma unroll
        for (int h = 0; h < 2; ++h)
#pragma unroll
            for (int i = 0; i < 2; ++i) nvA[h][i] = vA[h][i];
        if (has_next) { nA = P.a_base(nxt); nB = P.b_base(nxt); P.a_offs(nxt, Rr, Cc, nvA); }
        for (int t = 0; t < nt; t += 2) {
            const bool last = (t == nt - 2);
            const char* a1 = cA + (size_t)(t + 1) * kstep;
            const char* a2 = last ? nA : cA + (size_t)(t + 2) * kstep; const char* b2 = last ? nB : cB + (size_t)(t + 2) * kstep;
            const char* a3 = a2 + kstep; const char* b3 = b2 + kstep;
            unsigned o2a[2], o2b[2];
#pragma unroll
            for (int i = 0; i < 2; ++i) { o2a[i] = last ? nvA[0][i] : vA[0][i]; o2b[i] = last ? nvA[1][i] : vA[1][i]; }
            PG8_LDB(B0, 0, 0); PG8_LDB(B1, 0, 1); PG8_SCHED; PG8_LDA(At, 0, 0); PG8_STAGE(PG8_SA(1, 1), a1, vA[1]);
            PG8_WAIT_V(8); PG8_WAIT_L(0); PG8_BAR; PG8_MMA(0, 0, At, B0); PG8_MMA(0, 1, At, B1); PG8_BAR; PG8_SCHED;
            PG8_LDA(At, 0, 1); PG8_STAGE(PG8_SB(0, 0), b2, voffB); PG8_STAGE(PG8_SB(0, 1), b2 + hstepB, voffB); PG8_STAGE(PG8_SA(0, 0), a2, o2a);
            PG8_WAIT_V(8); PG8_WAIT_L(0); PG8_BAR; PG8_MMA(1, 0, At, B0); PG8_MMA(1, 1, At, B1); PG8_BAR; PG8_SCHED;
            PG8_LDB(B0, 1, 0); PG8_LDB(B1, 1, 1); PG8_SCHED; PG8_LDA(At, 1, 0); PG8_STAGE(PG8_SA(0, 1), a2, o2b);
            PG8_WAIT_V(8); PG8_WAIT_L(0); PG8_BAR; PG8_MMA(0, 0, At, B0); PG8_MMA(0, 1, At, B1); PG8_BAR; PG8_SCHED;
            PG8_LDA(At, 1, 1); PG8_STAGE(PG8_SB(1, 0), b3, voffB); PG8_STAGE(PG8_SB(1, 1), b3 + hstepB, voffB); PG8_STAGE(PG8_SA(1, 0), a3, o2a);
            PG8_WAIT_V(8); PG8_WAIT_L(0); PG8_BAR; PG8_MMA(1, 0, At, B0); PG8_MMA(1, 1, At, B1); PG8_BAR; PG8_SCHED;
        }
        if constexpr (ALIGN_EPI) { if (wr == 0) PG8_BAR; }
        if constexpr (!Epi::AFTER_DRAIN) { E(acc, cur, wr, wc, fr, fq); }
        if (!has_next) break;
#pragma unroll
        for (int a = 0; a < 2; ++a)
#pragma unroll
            for (int b = 0; b < 2; ++b)
#pragma unroll
                for (int m = 0; m < 4; ++m)
#pragma unroll
                    for (int n = 0; n < 2; ++n) acc[a][b][m][n] = (f32x4){0.f, 0.f, 0.f, 0.f};
        cur = nxt; cA = nA; cB = nB; ++ui;
#pragma unroll
        for (int h = 0; h < 2; ++h)
#pragma unroll
            for (int i = 0; i < 2; ++i) vA[h][i] = nvA[h][i];
        if constexpr (ALIGN_EPI) { if (wr == 1) PG8_BAR; }
    }
    PG8_WAIT_V(0);
    if constexpr (!ALIGN_EPI) { if (wr == 0) PG8_BAR; }
    PG8_BAR;
    if constexpr (Epi::AFTER_DRAIN) { E.fused(acc, cur, wr, wc, fr, fq, lds, wid, lane); }
#undef PG8_SA
#undef PG8_SB
#undef PG8_STAGE
#undef PG8_LDA
#undef PG8_LDB
#undef PG8_MMA
#undef PG8_CAT
#undef PG8_WAIT_V
#undef PG8_WAIT_L
#undef PG8_BAR
#undef PG8_SCHED
}
}

constexpr int NWAVES = 8;
struct Args {
    const float* in[25]; float* out; unsigned char* ws; int ph_lo, ph_hi;
};
static_assert(sizeof(Args) == 224, "Args layout (kernarg offsets in ka_ptr users)");
struct Frame {
    lds_u8* lds; volatile LAS unsigned* MISC; gu32* ctl;
    int tid, lane, wave, G, bid;
};
__device__ __forceinline__ void relaunder(Frame& F) { int t = threadIdx.x; asm volatile("" : "+v"(t)); F.tid = t; F.lane = t & 63; F.wave = __builtin_amdgcn_readfirstlane(t >> 6); int b = blockIdx.x; asm volatile("" : "+s"(b)); F.bid = b; }


typedef const unsigned char* cptr_t;
__device__ __forceinline__ cptr_t ka_ptr(int off) { const __attribute__((address_space(4))) unsigned char* p = (const __attribute__((address_space(4))) unsigned char*)__builtin_amdgcn_kernarg_segment_ptr(); asm volatile("" : "+s"(p)); return *(const __attribute__((address_space(4))) cptr_t*)(p + off); }
#define INP(i) ((const float*)ka_ptr(8 * (i)))
#define OUTP ((float*)ka_ptr(200))
#define WSP ((unsigned char*)ka_ptr(208))

struct Row { f32x4 v[8]; };
__device__ __forceinline__ void row_load_f32(Row& r, const float* p, int lane) {
#pragma unroll
    for (int j = 0; j < 4; ++j) { const f32x4* q = (const f32x4*)(p + 512 * j + 8 * lane); r.v[2 * j] = q[0]; r.v[2 * j + 1] = q[1]; }
}
__device__ __forceinline__ void row_store_f32(const Row& r, float* p, int lane) {
#pragma unroll
    for (int j = 0; j < 4; ++j) { f32x4* q = (f32x4*)(p + 512 * j + 8 * lane); q[0] = r.v[2 * j]; q[1] = r.v[2 * j + 1]; }
}
__device__ __forceinline__ void row_store_bf16(const Row& r, bf16* p, int lane) {
#pragma unroll
    for (int j = 0; j < 4; ++j) { const f32x4 a = r.v[2 * j], b = r.v[2 * j + 1]; u32x4 w; w.x = cvt_pk_bf16(a[0], a[1]); w.y = cvt_pk_bf16(a[2], a[3]); w.z = cvt_pk_bf16(b[0], b[1]); w.w = cvt_pk_bf16(b[2], b[3]);
        *(u32x4*)(p + 512 * j + 8 * lane) = w; }
}
__device__ __forceinline__ void row_add_bf16(Row& r, const bf16* p, int lane) {
#pragma unroll
    for (int j = 0; j < 4; ++j) { const u32x4 w = *(const u32x4*)(p + 512 * j + 8 * lane);
        r.v[2 * j] += (f32x4){bf_lo(w.x), bf_hi(w.x), bf_lo(w.y), bf_hi(w.y)}; r.v[2 * j + 1] += (f32x4){bf_lo(w.z), bf_hi(w.z), bf_lo(w.w), bf_hi(w.w)}; }
}
__device__ __forceinline__ void row_add_fp8(Row& r, const unsigned char* p, int lane, float sc) {
#pragma unroll
    for (int j = 0; j < 4; ++j) { const u32x2 w = *(const u32x2*)(p + 512 * j + 8 * lane);
        const f32x2 a = __builtin_amdgcn_cvt_pk_f32_fp8((int)w.x, false), b = __builtin_amdgcn_cvt_pk_f32_fp8((int)w.x, true), c = __builtin_amdgcn_cvt_pk_f32_fp8((int)w.y, false), d = __builtin_amdgcn_cvt_pk_f32_fp8((int)w.y, true);
        r.v[2 * j] += (f32x4){a.x, a.y, b.x, b.y} * sc; r.v[2 * j + 1] += (f32x4){c.x, c.y, d.x, d.y} * sc; }
}
__device__ __forceinline__ void row_layernorm(Row& r, const Row& g, const Row& b) {
    float s = 0.f;
#pragma unroll
    for (int i = 0; i < 8; ++i) s += (r.v[i][0] + r.v[i][1]) + (r.v[i][2] + r.v[i][3]);
    const float mean = wave_sum(s) * (1.0f / D); float s2 = 0.f;
#pragma unroll
    for (int i = 0; i < 8; ++i) { r.v[i] = r.v[i] - mean; s2 += (r.v[i][0] * r.v[i][0] + r.v[i][1] * r.v[i][1]) + (r.v[i][2] * r.v[i][2] + r.v[i][3] * r.v[i][3]); }
    const float rstd = 1.0f / sqrtf(wave_sum(s2) * (1.0f / D) + LN_EPS);
#pragma unroll
    for (int i = 0; i < 8; ++i) r.v[i] = r.v[i] * rstd * g.v[i] + b.v[i];
}

__device__ __forceinline__ void tr_item(const float* W, int N, int k0, int n0, bf16* WT, size_t orow0, int K, LAS float* scr, int lane) {
    f32x4 v[16];
#pragma unroll
    for (int i = 0; i < 16; ++i) v[i] = *(const f32x4*)(W + (size_t)(k0 + 4 * i + (lane >> 4)) * N + n0 + 4 * (lane & 15));
#pragma unroll
    for (int i = 0; i < 16; ++i) { LAS float* s = scr + (4 * i + (lane >> 4)) * 65 + 4 * (lane & 15); s[0] = v[i][0]; s[1] = v[i][1]; s[2] = v[i][2]; s[3] = v[i][3]; }
    LDS_WAIT(); asm volatile("" ::: "memory");
    const int c = lane >> 3;
#pragma unroll
    for (int p = 0; p < 8; ++p) { const int n = 8 * p + (lane & 7); const LAS float* s = scr + (8 * c) * 65 + n;
        u32x4 o; o.x = cvt_pk_bf16(s[0 * 65], s[1 * 65]); o.y = cvt_pk_bf16(s[2 * 65], s[3 * 65]); o.z = cvt_pk_bf16(s[4 * 65], s[5 * 65]); o.w = cvt_pk_bf16(s[6 * 65], s[7 * 65]);
        *(u32x4*)(WT + (orow0 + n) * (size_t)K + k0 + 8 * c) = o; }
    LDS_WAIT(); asm volatile("" ::: "memory");
}
__device__ __forceinline__ void tr_item8(const float* W, int N, int k0, int n0, unsigned char* WT, size_t orow0, int K, LAS float* scr, int lane, float sc) {
    f32x4 v[16];
#pragma unroll
    for (int i = 0; i < 16; ++i) v[i] = *(const f32x4*)(W + (size_t)(k0 + 4 * i + (lane >> 4)) * N + n0 + 4 * (lane & 15));
#pragma unroll
    for (int i = 0; i < 16; ++i) { LAS float* s = scr + (4 * i + (lane >> 4)) * 65 + 4 * (lane & 15); s[0] = v[i][0] * sc; s[1] = v[i][1] * sc; s[2] = v[i][2] * sc; s[3] = v[i][3] * sc; }
    LDS_WAIT(); asm volatile("" ::: "memory");
    const int c = lane >> 4;
#pragma unroll
    for (int p = 0; p < 4; ++p) { const int n = 16 * p + (lane & 15); const LAS float* s = scr + (16 * c) * 65 + n;
        int w[4];
#pragma unroll
        for (int q = 0; q < 4; ++q) { int x = 0; x = __builtin_amdgcn_cvt_pk_fp8_f32(s[(4 * q + 0) * 65], s[(4 * q + 1) * 65], x, false); x = __builtin_amdgcn_cvt_pk_fp8_f32(s[(4 * q + 2) * 65], s[(4 * q + 3) * 65], x, true); w[q] = x; }
        u32x4 o; o.x = (unsigned)w[0]; o.y = (unsigned)w[1]; o.z = (unsigned)w[2]; o.w = (unsigned)w[3];
        *(u32x4*)(WT + (orow0 + n) * (size_t)K + k0 + 16 * c) = o; }
    LDS_WAIT(); asm volatile("" ::: "memory");
}
template <bool GU> __device__ __forceinline__ void tr_matrix_item(const float* W, int K, int N, bf16* WT, size_t orow_base, int item, LAS float* scr, int lane) {
    const int nblk = N / 64, kb = item / nblk, nb = item % nblk, n0 = nb * 64;
    const size_t orow0 = orow_base + (GU ? (size_t)((n0 >> 7) * 256 + (n0 & 127)) : (size_t)n0);
    tr_item(W, N, kb * 64, n0, WT, orow0, K, scr, lane);
}

template <bool GU> __device__ __forceinline__ void tr_matrix_item8(const float* W, int K, int N, unsigned char* WT, size_t orow_base, int item, LAS float* scr, int lane, float sc) {
    const int nblk = N / 64, kb = item / nblk, nb = item % nblk, n0 = nb * 64;
    const size_t orow0 = orow_base + (GU ? (size_t)((n0 >> 7) * 256 + (n0 & 127)) : (size_t)n0);
    tr_item8(W, N, kb * 64, n0, WT, orow0, K, scr, lane, sc);
}

constexpr int ATT_ROWB = 160;
constexpr int ATT_TILE = 272 * ATT_ROWB;
typedef short v4i16_t __attribute__((ext_vector_type(4)));
__device__ __forceinline__ s16x4 vtr(const lds_u8* p) { return __builtin_bit_cast(s16x4, __builtin_amdgcn_ds_read_tr16_b64_v4i16((LAS v4i16_t*)p)); }
struct AttnDesc { int kind, h, d, nb, tile_id; size_t tok0; int qcol, kcol, vcol; };
__device__ __forceinline__ AttnDesc attn_desc(int it, int bid) {
    AttnDesc a;
    if (it < 8) { const int b = bid >> 6, hk = (bid >> 5) & 1, nb = bid & 31; a.kind = 0; a.h = hk * 8 + it; a.d = 1; a.nb = nb; a.tok0 = (size_t)b * SEQ; a.tile_id = 0;
        a.qcol = a.h * 64; a.kcol = 1024 + hk * 64; a.vcol = 1152 + hk * 64; }
    else { const int u = bid * 24 + (it - 8), br = u >> 11, rem = u & 2047, b = rem >> 9, h = (rem >> 5) & 15, j32 = rem & 31;
        const int dsh = 2 * br, nbpr = 32 >> dsh; const int r = j32 / nbpr; a.kind = 1 + br; a.h = h; a.d = 1 << dsh; a.nb = j32 % nbpr; a.tok0 = (size_t)b * SEQ + r; a.tile_id = it;
        a.qcol = 1280 + h * 64; a.kcol = 2304 + h * 64; a.vcol = 3328 + h * 64; }
    return a;
}
__device__ __forceinline__ void attn_phase(Frame& F, const bf16* proj, const float* sinks, bf16* oA, bf16* oB, float* lseB) {
    lds_u8* Kt = F.lds; lds_u8* Vt = F.lds + ATT_TILE;
    const int tid = F.tid, wid = F.wave, lane = F.lane, fr = lane & 15, fq = lane >> 4;
    for (int i = tid; i < 2 * 640; i += NWAVES * 64) { lds_u8* base = (i >= 640) ? Vt : Kt; *(LAS unsigned*)(base + 256 * ATT_ROWB + (i % 640) * 4) = 0u; }
    u32x4 kreg[4], vreg[4]; bf16x8 qn0, qn1;
    AttnDesc cur = attn_desc(0, F.bid);
    {
#pragma unroll
        for (int i = 0; i < 4; ++i) { const int row = (tid >> 3) + 64 * i, c = tid & 7; int t = (cur.nb - 1) * 128 + row; t = t < 0 ? 0 : t;
            const bf16* src = proj + (cur.tok0 + (size_t)cur.d * t) * INW + c * 8; kreg[i] = *(const u32x4*)(src + cur.kcol); vreg[i] = *(const u32x4*)(src + cur.vcol); }
        const size_t tokq = cur.tok0 + (size_t)cur.d * (cur.nb * 128 + wid * 16 + fr);
        qn0 = *(const bf16x8*)(proj + tokq * INW + cur.qcol + 8 * fq); qn1 = *(const bf16x8*)(proj + tokq * INW + cur.qcol + 32 + 8 * fq);
    }
    bool need_stage = true;
#pragma unroll 1
    for (int it = 0; it < 32; ++it) {
        const int kind = cur.kind, h = cur.h, d = cur.d, nb = cur.nb;
        const int max_off = (kind == 0) ? 127 : 128;
        const float slope2 = __builtin_amdgcn_exp2f(-0.5f * (float)(h + 1)) * (float)d * LOG2E;
        const float sink2 = (kind == 0) ? sinks[h] * LOG2E : -__builtin_inff();
        const size_t tokq = cur.tok0 + (size_t)d * (nb * 128 + wid * 16 + fr);
        __syncthreads();
        if (need_stage) {
#pragma unroll
            for (int i = 0; i < 4; ++i) { const int row = (tid >> 3) + 64 * i, c = tid & 7; *(LAS u32x4*)(Kt + row * ATT_ROWB + c * 16) = kreg[i]; *(LAS u32x4*)(Vt + row * ATT_ROWB + c * 16) = vreg[i]; }
        }
        const bf16x8 q0 = qn0, q1 = qn1;
        __syncthreads();
        if (it + 1 < 32) {
            const AttnDesc nx = attn_desc(it + 1, F.bid);
            need_stage = (nx.tile_id != cur.tile_id);
            if (need_stage) {
#pragma unroll
                for (int i = 0; i < 4; ++i) { const int row = (tid >> 3) + 64 * i, c = tid & 7; int t = (nx.nb - 1) * 128 + row; t = t < 0 ? 0 : t;
                    const bf16* src = proj + (nx.tok0 + (size_t)nx.d * t) * INW + c * 8; kreg[i] = *(const u32x4*)(src + nx.kcol); vreg[i] = *(const u32x4*)(src + nx.vcol); }
            }
            const size_t tokn = nx.tok0 + (size_t)nx.d * (nx.nb * 128 + wid * 16 + fr);
            qn0 = *(const bf16x8*)(proj + tokn * INW + nx.qcol + 8 * fq); qn1 = *(const bf16x8*)(proj + tokn * INW + nx.qcol + 32 + 8 * fq);
            cur = nx;
        }
        f32x4 s[9];
#pragma unroll
        for (int j = 0; j < 9; ++j) { const lds_u8* kp = Kt + (16 * (wid + j) + fr) * ATT_ROWB + fq * 16;
            const bf16x8 a0 = *(const LAS bf16x8*)kp, a1 = *(const LAS bf16x8*)(kp + 64);
            f32x4 z = (f32x4){0.f, 0.f, 0.f, 0.f}; z = __builtin_amdgcn_mfma_f32_16x16x32_bf16(a0, q0, z, 0, 0, 0); s[j] = __builtin_amdgcn_mfma_f32_16x16x32_bf16(a1, q1, z, 0, 0, 0); }
        float te[4];
#pragma unroll
        for (int e = 0; e < 4; ++e) te[e] = slope2 * (float)(128 + fr - 4 * fq - e);
        const int cut0 = max_off - 128;
#pragma unroll
        for (int j = 0; j < 9; ++j) { const float uj = slope2 * (16.0f * (float)j);
#pragma unroll
            for (int e = 0; e < 4; ++e) { float v = fmaf(s[j][e], 0.125f * LOG2E, uj - te[e]); const int dl = fr - 4 * fq - e;
                if (j == 0) v = (dl <= cut0) ? v : -__builtin_inff();
                if (j == 8) v = (dl >= 0) ? v : -__builtin_inff();
                s[j][e] = v; } }
        if (nb == 0) {
#pragma unroll
            for (int j = 0; j < 9; ++j)
#pragma unroll
                for (int e = 0; e < 4; ++e) s[j][e] = (16 * (wid + j) + 4 * fq + e >= 128) ? s[j][e] : -__builtin_inff(); }
        float mx = -__builtin_inff();
#pragma unroll
        for (int j = 0; j < 9; ++j) mx = fmaxf(mx, fmaxf(fmaxf(s[j][0], s[j][1]), fmaxf(s[j][2], s[j][3])));
        mx = fmaxf(mx, __shfl_xor(mx, 16)); mx = fmaxf(mx, __shfl_xor(mx, 32)); mx = fmaxf(mx, sink2);
        float sum = 0.f;
#pragma unroll
        for (int j = 0; j < 9; ++j)
#pragma unroll
            for (int e = 0; e < 4; ++e) { const float p = __builtin_amdgcn_exp2f(s[j][e] - mx); s[j][e] = p; sum += p; }
        sum += __shfl_xor(sum, 16); sum += __shfl_xor(sum, 32); sum += __builtin_amdgcn_exp2f(sink2 - mx);
        bf16x8 pb[5];
#pragma unroll
        for (int ks = 0; ks < 5; ++ks) { u32x4 w; w.x = cvt_pk_bf16(s[2 * ks][0], s[2 * ks][1]); w.y = cvt_pk_bf16(s[2 * ks][2], s[2 * ks][3]);
            if (ks < 4) { w.z = cvt_pk_bf16(s[2 * ks + 1][0], s[2 * ks + 1][1]); w.w = cvt_pk_bf16(s[2 * ks + 1][2], s[2 * ks + 1][3]); } else { w.z = 0u; w.w = 0u; }
            pb[ks] = __builtin_bit_cast(bf16x8, w); }
        f32x4 o[4];
#pragma unroll
        for (int dt = 0; dt < 4; ++dt) { f32x4 z = (f32x4){0.f, 0.f, 0.f, 0.f};
#pragma unroll
            for (int ks = 0; ks < 5; ++ks) { const lds_u8* vp = Vt + (16 * (wid + 2 * ks) + 4 * fq + (fr >> 2)) * ATT_ROWB + (16 * dt + 4 * (fr & 3)) * 2;
                const s16x4 v0 = vtr(vp), v1 = vtr(vp + 16 * ATT_ROWB);
                const bf16x8 a = (bf16x8){v0[0], v0[1], v0[2], v0[3], v1[0], v1[1], v1[2], v1[3]};
                z = __builtin_amdgcn_mfma_f32_16x16x32_bf16(a, pb[ks], z, 0, 0, 0); }
            o[dt] = z; }
        const float inv = 1.0f / sum;
        bf16* orow = ((kind == 0) ? oA : oB + (size_t)(kind - 1) * M * 1024) + tokq * 1024 + h * 64 + 4 * fq;
#pragma unroll
        for (int dt = 0; dt < 4; ++dt) { u32x2 w; w.x = cvt_pk_bf16(o[dt][0] * inv, o[dt][1] * inv); w.y = cvt_pk_bf16(o[dt][2] * inv, o[dt][3] * inv); *(u32x2*)(orow + 16 * dt) = w; }
        if (kind > 0 && fq == 0) lseB[((size_t)(kind - 1) * M + tokq) * 16 + h] = mx + __builtin_amdgcn_logf(sum);
    }
    __syncthreads();
}

__device__ __forceinline__ void merge_phase(Frame& F, const bf16* oA, const bf16* oB, const float* lseB, const float* ga, const float* gb, bf16* mixed) {
    const int lane = F.lane, gw = F.bid * NWAVES + F.wave, NGW = F.G * NWAVES;
    f32x4 gA[4], gB[4];
#pragma unroll
    for (int jj = 0; jj < 2; ++jj) { gA[2 * jj] = *(const f32x4*)(ga + 512 * jj + 8 * lane); gA[2 * jj + 1] = *(const f32x4*)(ga + 512 * jj + 8 * lane + 4);
        gB[2 * jj] = *(const f32x4*)(gb + 512 * jj + 8 * lane); gB[2 * jj + 1] = *(const f32x4*)(gb + 512 * jj + 8 * lane + 4); }
    for (int t = gw; t < M; t += NGW) {
        f32x4 a[4], bb[4];
        float ssa = 0.f, ssb = 0.f;
#pragma unroll
        for (int jj = 0; jj < 2; ++jj) {
            const int e0 = 512 * jj + 8 * lane, hh = e0 >> 6;
            const u32x4 w = *(const u32x4*)(oA + (size_t)t * 1024 + e0);
            a[2 * jj] = (f32x4){bf_lo(w.x), bf_hi(w.x), bf_lo(w.y), bf_hi(w.y)}; a[2 * jj + 1] = (f32x4){bf_lo(w.z), bf_hi(w.z), bf_lo(w.w), bf_hi(w.w)};
            float l0 = lseB[((size_t)0 * M + t) * 16 + hh], l1 = lseB[((size_t)1 * M + t) * 16 + hh], l2 = lseB[((size_t)2 * M + t) * 16 + hh];
            const float lm = fmaxf(l0, fmaxf(l1, l2)); l0 = __builtin_amdgcn_exp2f(l0 - lm); l1 = __builtin_amdgcn_exp2f(l1 - lm); l2 = __builtin_amdgcn_exp2f(l2 - lm);
            const float li = 1.0f / (l0 + l1 + l2); l0 *= li; l1 *= li; l2 *= li;
            const u32x4 w0 = *(const u32x4*)(oB + ((size_t)0 * M + t) * 1024 + e0), w1 = *(const u32x4*)(oB + ((size_t)1 * M + t) * 1024 + e0), w2 = *(const u32x4*)(oB + ((size_t)2 * M + t) * 1024 + e0);
            bb[2 * jj] = (f32x4){bf_lo(w0.x), bf_hi(w0.x), bf_lo(w0.y), bf_hi(w0.y)} * l0 + (f32x4){bf_lo(w1.x), bf_hi(w1.x), bf_lo(w1.y), bf_hi(w1.y)} * l1 + (f32x4){bf_lo(w2.x), bf_hi(w2.x), bf_lo(w2.y), bf_hi(w2.y)} * l2;
            bb[2 * jj + 1] = (f32x4){bf_lo(w0.z), bf_hi(w0.z), bf_lo(w0.w), bf_hi(w0.w)} * l0 + (f32x4){bf_lo(w1.z), bf_hi(w1.z), bf_lo(w1.w), bf_hi(w1.w)} * l1 + (f32x4){bf_lo(w2.z), bf_hi(w2.z), bf_lo(w2.w), bf_hi(w2.w)} * l2;
        }
#pragma unroll
        for (int i = 0; i < 4; ++i) { ssa += (a[i][0] * a[i][0] + a[i][1] * a[i][1]) + (a[i][2] * a[i][2] + a[i][3] * a[i][3]); ssb += (bb[i][0] * bb[i][0] + bb[i][1] * bb[i][1]) + (bb[i][2] * bb[i][2] + bb[i][3] * bb[i][3]); }
        const float ra = 1.0f / sqrtf(wave_sum(ssa) * (1.0f / 1024.0f) + RMS_EPS), rb = 1.0f / sqrtf(wave_sum(ssb) * (1.0f / 1024.0f) + RMS_EPS);
#pragma unroll
        for (int jj = 0; jj < 2; ++jj) { const int e0 = 512 * jj + 8 * lane;
            const f32x4 x0 = a[2 * jj] * ra * gA[2 * jj], x1 = a[2 * jj + 1] * ra * gA[2 * jj + 1], y0 = bb[2 * jj] * rb * gB[2 * jj], y1 = bb[2 * jj + 1] * rb * gB[2 * jj + 1];
            u32x4 w; w.x = cvt_pk_bf16(x0[0], x0[1]); w.y = cvt_pk_bf16(x0[2], x0[3]); w.z = cvt_pk_bf16(x1[0], x1[1]); w.w = cvt_pk_bf16(x1[2], x1[3]);
            *(u32x4*)(mixed + (size_t)t * D + e0) = w;
            w.x = cvt_pk_bf16(y0[0], y0[1]); w.y = cvt_pk_bf16(y0[2], y0[3]); w.z = cvt_pk_bf16(y1[0], y1[1]); w.w = cvt_pk_bf16(y1[2], y1[3]);
            *(u32x4*)(mixed + (size_t)t * D + 1024 + e0) = w; }
    }
}

__device__ __forceinline__ void row_store_fp8(const Row& r, unsigned char* p, int lane) {
#pragma unroll
    for (int j = 0; j < 4; ++j) { const f32x4 a = r.v[2 * j], b = r.v[2 * j + 1]; int w0 = 0, w1 = 0;
        w0 = __builtin_amdgcn_cvt_pk_fp8_f32(a[0], a[1], w0, false); w0 = __builtin_amdgcn_cvt_pk_fp8_f32(a[2], a[3], w0, true); w1 = __builtin_amdgcn_cvt_pk_fp8_f32(b[0], b[1], w1, false); w1 = __builtin_amdgcn_cvt_pk_fp8_f32(b[2], b[3], w1, true);
        u32x2 w; w.x = (unsigned)w0; w.y = (unsigned)w1; *(u32x2*)(p + 512 * j + 8 * lane) = w; }
}
__device__ __forceinline__ void ln_phase(Frame& F, const float* y, const float* g, const float* b, float* hout, bf16* hb, unsigned char* hb8) {
    const int lane = F.lane, gw = F.bid * NWAVES + F.wave, NGW = F.G * NWAVES;
    Row rg, rb; row_load_f32(rg, g, lane); row_load_f32(rb, b, lane);
    for (int t = gw; t < M; t += NGW) { Row r; row_load_f32(r, y + (size_t)t * D, lane); row_layernorm(r, rg, rb); row_store_f32(r, hout + (size_t)t * D, lane); if (hb) row_store_bf16(r, hb + (size_t)t * D, lane); if (hb8) row_store_fp8(r, hb8 + (size_t)t * D, lane); }
}

__device__ __forceinline__ void router_phase(Frame& F, const float* h, const float* wr_, const float* rbias, gu32* cnt, int* tok_e, int* tok_slot, float* tok_gate, int* row_tok, float* row_gate) {
    const int tid = F.tid, wid = F.wave, lane = F.lane, fr = lane & 15, fq = lane >> 4;
    LAS float* sc = (LAS float*)F.lds;
    LAS int* lcnt = (LAS int*)(F.lds + 17408);
    LAS int* gbase = (LAS int*)(F.lds + 17408 + 256);
    LAS int* ti_e = (LAS int*)(F.lds + 18432);
    LAS int* ti_ls = (LAS int*)(F.lds + 18432 + 2048);
    LAS float* ti_g = (LAS float*)(F.lds + 18432 + 4096);
    for (int i = F.bid * NWAVES * 64 + tid; i < NROWS; i += F.G * NWAVES * 64) { const bool sh = i >= RB_SHARED0 * 256; row_tok[i] = sh ? i - RB_SHARED0 * 256 : 0; row_gate[i] = sh ? 1.0f : 0.0f; }
    for (int grp = F.bid; grp < M / 64; grp += F.G) {
        if (tid < 64) lcnt[tid] = 0;
        {
            constexpr int RDEPTH = 4, NIT = 64;
            f32x4 acc[4];
#pragma unroll
            for (int n = 0; n < 4; ++n) acc[n] = (f32x4){0.f, 0.f, 0.f, 0.f};
            const int kh = wid >> 2, ws4 = wid & 3;
            const float* xrow = h + (size_t)(grp * 64 + ws4 * 16 + fr) * D + kh * 1024 + 4 * fq;
            const float* wb = wr_ + (size_t)(kh * 1024 + 4 * fq) * NE + 4 * fr;
            f32x4 ra[RDEPTH], rb[RDEPTH][4];
#pragma unroll
            for (int i = 0; i < RDEPTH; ++i) { ra[i] = *(const f32x4*)(xrow + 16 * i);
#pragma unroll
                for (int s = 0; s < 4; ++s) rb[i][s] = *(const f32x4*)(wb + (size_t)(16 * i + s) * NE); }
#pragma unroll 1
            for (int it = 0; it < NIT; it += RDEPTH) {
#pragma unroll
                for (int u = 0; u < RDEPTH; ++u) {
                    const f32x4 a = ra[u]; f32x4 bq[4];
#pragma unroll
                    for (int s = 0; s < 4; ++s) bq[s] = rb[u][s];
                    if (it + RDEPTH < NIT) { const int nx = it + RDEPTH + u; ra[u] = *(const f32x4*)(xrow + 16 * nx);
#pragma unroll
                        for (int s = 0; s < 4; ++s) rb[u][s] = *(const f32x4*)(wb + (size_t)(16 * nx + s) * NE); }
#pragma unroll
                    for (int s = 0; s < 4; ++s)
#pragma unroll
                        for (int n = 0; n < 4; ++n) acc[n] = __builtin_amdgcn_mfma_f32_16x16x4f32(a[s], bq[s][n], acc[n], 0, 0, 0);
                }
            }
            if (kh == 1) {
#pragma unroll
                for (int n = 0; n < 4; ++n)
#pragma unroll
                    for (int e = 0; e < 4; ++e) sc[(ws4 * 16 + 4 * fq + e) * 65 + 4 * fr + n] = acc[n][e];
            }
            __syncthreads();
            if (kh == 0) {
#pragma unroll
                for (int n = 0; n < 4; ++n)
#pragma unroll
                    for (int e = 0; e < 4; ++e) sc[(ws4 * 16 + 4 * fq + e) * 65 + 4 * fr + n] += acc[n][e];
            }
        }
        __syncthreads();
        const float bias = rbias[lane];
        for (int ti = 0; ti < 8; ++ti) {
            const int tl = wid * 8 + ti;
            const float logit = sc[tl * 65 + lane];
            const float score = 1.0f / (1.0f + __expf(-logit));
            const float selv = score + bias;
            float m1 = selv;
#pragma unroll
            for (int o = 1; o < 8; o <<= 1) m1 = fmaxf(m1, __shfl_xor(m1, o));
            int i1 = (selv == m1) ? lane : 64;
#pragma unroll
            for (int o = 1; o < 8; o <<= 1) { const int x = __shfl_xor(i1, o); i1 = x < i1 ? x : i1; }
            float m2 = (lane == i1) ? -__builtin_inff() : selv;
#pragma unroll
            for (int o = 1; o < 8; o <<= 1) m2 = fmaxf(m2, __shfl_xor(m2, o));
            const float gs = m1 + m2; const int gi = lane >> 3;
            int rg = 0;
#pragma unroll
            for (int j = 0; j < 8; ++j) { const float og = __shfl(gs, 8 * j); rg += ((og > gs) || (og == gs && j < gi)) ? 1 : 0; }
            const bool gsel = rg < 4;
            const float mv = gsel ? selv : -__builtin_inff();
            int rk = 0;
#pragma unroll 4
            for (int j = 0; j < 64; ++j) { const float ov = __shfl(mv, j); rk += ((ov > mv) || (ov == mv && j < lane)) ? 1 : 0; }
            const bool chosen = gsel && (rk < TOPK);
            const float ssum = wave_sum(chosen ? score : 0.0f);
            if (chosen) { const int ls = __hip_atomic_fetch_add(lcnt + lane, 1, __ATOMIC_RELAXED, __HIP_MEMORY_SCOPE_WORKGROUP); ti_e[tl * 8 + rk] = lane; ti_ls[tl * 8 + rk] = ls; ti_g[tl * 8 + rk] = score / ssum * 2.5f; }
        }
        __syncthreads();
        if (tid < 64) gbase[tid] = (int)__hip_atomic_fetch_add((unsigned*)(cnt + tid), (unsigned)lcnt[tid], RLX_AGENT);
        __syncthreads();
        { const int e = ti_e[tid]; const size_t gi = (size_t)grp * 512 + tid; tok_e[gi] = e; tok_slot[gi] = gbase[e] + ti_ls[tid]; tok_gate[gi] = ti_g[tid]; }
        __syncthreads();
    }
}

__device__ __forceinline__ void scatter_phase(Frame& F, const gu32* cnt, const int* tok_e, const int* tok_slot, const float* tok_gate, int* tok_pos, int* row_tok, float* row_gate, int* meta) {
    LAS int* pstart = (LAS int*)F.lds;
    if (F.tid == 0) { int acc = 0; for (int e = 0; e < NE; ++e) { pstart[e] = acc; const int c = (int)__hip_atomic_load(cnt + e, RLX_AGENT); acc += (c + 255) >> 8; } pstart[NE] = acc; }
    __syncthreads();
    if (F.bid == 0) {
        if (F.tid == 0) meta[0] = pstart[NE];
        if (F.tid < NE) { for (int b = pstart[F.tid]; b < pstart[F.tid + 1]; ++b) meta[16 + b] = F.tid; }
    }
    for (int i = F.bid * NWAVES * 64 + F.tid; i < M * TOPK; i += F.G * NWAVES * 64) {
        const int e = tok_e[i], pos = pstart[e] * 256 + tok_slot[i];
        row_tok[pos] = i >> 3; row_gate[pos] = tok_gate[i]; tok_pos[i] = pos;
    }
}

__device__ __forceinline__ void combine_phase(Frame& F, const float* hres, const unsigned char* yrows, const int* tok_pos, const float* g, const float* b, float* hout, bf16* hb) {
    const int lane = F.lane, gw = F.bid * NWAVES + F.wave, NGW = F.G * NWAVES;
    Row rg, rb; row_load_f32(rg, g, lane); row_load_f32(rb, b, lane);
    for (int t = gw; t < M; t += NGW) {
        Row r; row_load_f32(r, hres + (size_t)t * D, lane);
#pragma unroll
        for (int i = 0; i < 8; ++i) r.v[i] = r.v[i] * ALPHA;
        int pos[8];
#pragma unroll
        for (int k = 0; k < 8; ++k) pos[k] = tok_pos[(size_t)t * 8 + k];
#pragma unroll
        for (int k = 0; k < 8; ++k) row_add_fp8(r, yrows + (size_t)pos[k] * D, lane, 0.0625f);
        row_add_fp8(r, yrows + (size_t)(RB_SHARED0 * 256 + t) * D, lane, 0.0625f);
        row_layernorm(r, rg, rb);
        row_store_f32(r, hout + (size_t)t * D, lane); if (hb) row_store_bf16(r, hb + (size_t)t * D, lane);
    }
}

constexpr int NPH_LAYER = 16, NPH = 2 + DEPTH * NPH_LAYER;
constexpr size_t SZ_WIN = (size_t)D * INW, SZ_DD = (size_t)D * D, SZ_EXP = (size_t)D * DE;

__global__ void __launch_bounds__(NWAVES * 64, 2) mk_fwd(Args args) {
    extern __shared__ __attribute__((aligned(16))) unsigned char lds_raw[];
    Frame F;
    F.lds = (lds_u8*)lds_raw; F.MISC = (volatile LAS unsigned*)(F.lds + MISC_OFF);
    F.tid = threadIdx.x; F.lane = F.tid & 63; F.wave = __builtin_amdgcn_readfirstlane(F.tid >> 6); F.G = gridDim.x; F.bid = blockIdx.x;
    F.ctl = (gu32*)(WSP + WS_CTL);
    if (F.tid < 64) F.MISC[F.tid] = 0u;
    __syncthreads();
    const int lo = args.ph_lo, hi = args.ph_hi;
    const bool use_bar = (hi - lo) > 1;
    XcdBarrier bar; bar.bar = (unsigned*)(F.ctl + CW_BAR); bar.x = 0; bar.st = nullptr;
    if (use_bar) bar = xcd_barrier_post((unsigned*)(F.ctl + CW_BAR), F.MISC + 8);
#define IN(k) (lo <= (k) && (k) < hi)
#ifndef MK_BAR_REP
#define MK_BAR_REP 1
#endif
#define SEAM(k) do { if (IN(k) && IN((k) + 1)) { for (int br_ = 0; br_ < MK_BAR_REP; ++br_) xcd_barrier(bar); } } while (0)

#define xin ((const float*)INP(0))
#define memb ((bf16*)(WSP + WS_MEMB))
#define Kc ((bf16*)(WSP + WS_KC))
#define VT ((bf16*)(WSP + WS_VT))
#define WinT ((bf16*)(WSP + WS_WIN))
#define WoutT ((bf16*)(WSP + WS_WOUT))
#define WqT ((bf16*)(WSP + WS_WQ))
#define WoT ((bf16*)(WSP + WS_WO))
#define WguT ((bf16*)(WSP + WS_WGU))
#define WdT ((bf16*)(WSP + WS_WD))
#define hbuf ((float*)(WSP + WS_H))
#define hb ((bf16*)(WSP + WS_HB))
#define ybuf ((float*)(WSP + WS_Y))
#define proj ((bf16*)(WSP + WS_PROJ))
#define oA ((bf16*)(WSP + WS_OA))
#define oB ((bf16*)(WSP + WS_OB))
#define lseB ((float*)(WSP + WS_LSE))
#define mixed ((bf16*)(WSP + WS_MIXED))
#define qb ((bf16*)(WSP + WS_Q))
#define Pb ((bf16*)(WSP + WS_P))
#define ob ((bf16*)(WSP + WS_O))
#define WkT ((bf16*)(WSP + WS_WKT))
#define WvT ((bf16*)(WSP + WS_WVT))
#define hid ((bf16*)(WSP + WS_HID))
#define yrows ((bf16*)(WSP + WS_YROWS))
#define meta ((int*)(WSP + WS_META))
#define tok_e ((int*)(WSP + WS_TOKE))
#define tok_slot ((int*)(WSP + WS_TOKSLOT))
#define tok_gate ((float*)(WSP + WS_TOKGATE))
#define tok_pos ((int*)(WSP + WS_TOKPOS))
#define row_tok ((int*)(WSP + WS_ROWTOK))
#define row_gate ((float*)(WSP + WS_ROWGATE))

    if (KIND_EN(0) && IN(0)) for (int rep = 0; rep < NREP(0); ++rep) { relaunder(F);
        const int gw = F.bid * NWAVES + F.wave, NGW = F.G * NWAVES; LAS float* scr = (LAS float*)(F.lds + F.wave * 16640);
        { const float* xp = xin; bf16* hbp = hb;
        for (size_t i = (size_t)F.bid * NWAVES * 64 + F.tid; i < (size_t)M * D / 8; i += (size_t)F.G * NWAVES * 64) {
            const f32x4 a = *(const f32x4*)(xp + i * 8), b = *(const f32x4*)(xp + i * 8 + 4);
            u32x4 w; w.x = cvt_pk_bf16(a[0], a[1]); w.y = cvt_pk_bf16(a[2], a[3]); w.z = cvt_pk_bf16(b[0], b[1]); w.w = cvt_pk_bf16(b[2], b[3]); *(u32x4*)(hbp + i * 8) = w; } }
        { const float* mem = INP(1); bf16* mb = memb;
        for (size_t i = (size_t)F.bid * NWAVES * 64 + F.tid; i < (size_t)NBATCH * 256 * D / 8; i += (size_t)F.G * NWAVES * 64) {
            const f32x4 a = *(const f32x4*)(mem + i * 8), b = *(const f32x4*)(mem + i * 8 + 4);
            u32x4 w; w.x = cvt_pk_bf16(a[0], a[1]); w.y = cvt_pk_bf16(a[2], a[3]); w.z = cvt_pk_bf16(b[0], b[1]); w.w = cvt_pk_bf16(b[2], b[3]); *(u32x4*)(mb + i * 8) = w; } }
        { const float* wk = INP(10); const float* wv = INP(11); bf16* wkt = WkT; bf16* wvt = WvT;
        for (int it = gw; it < 4096; it += NGW) { const int mat = it >> 10, sub = it & 1023, l = mat & 1;
            const float* W = (mat < 2 ? wk : wv) + (size_t)l * SZ_DD;
            tr_matrix_item<false>(W, D, D, mat < 2 ? wkt : wvt, (size_t)l * D, sub, scr, F.lane); } }
    }
    SEAM(0);
    if (KIND_EN(1) && IN(1)) for (int rep = 0; rep < NREP(1); ++rep) { relaunder(F);
        { pg8::ProbStatic P{(const char*)memb, (const char*)WkT, D, D, D, (size_t)256 * D * 2, 0, 0, (size_t)256 * D * 2, 0, 1, {}}; P.S.init(4, 16, F.G, F.bid);
          pg8::EpiBf16 E{Kc, 2 * D, 1.0f}; pg8::gemm_phase<pg8::EpiBf16, pg8::ProbStatic, false>(F.lds, P, E, F.tid); }
        { pg8::ProbStatic P{(const char*)WvT, (const char*)memb, D, D, D, (size_t)256 * D * 2, 0, 0, (size_t)256 * D * 2, 0, 1, {}}; P.S.init(16, 4, F.G, (F.bid + F.G / 2) % F.G);
          pg8::EpiBf16 E{VT, 1024, 1.0f}; pg8::gemm_phase<pg8::EpiBf16, pg8::ProbStatic, false>(F.lds, P, E, F.tid); }
    }
    SEAM(1);

    for (int l = 0; l < DEPTH; ++l) {
        const int pb = 2 + NPH_LAYER * l;
        const float* hres = (l == 0) ? xin : hbuf;
        if (KIND_EN(2) && IN(pb + 0)) for (int rep = 0; rep < NREP(2); ++rep) { relaunder(F);
            const int gw = F.bid * NWAVES + F.wave, NGW = F.G * NWAVES; LAS float* scr = (LAS float*)(F.lds + F.wave * 16640);
            const float* w_in = INP(2) + (size_t)l * SZ_WIN; const float* w_out = INP(6) + (size_t)l * SZ_DD;
            const float* wq = INP(9) + (size_t)l * SZ_DD; const float* wo = INP(12) + (size_t)l * SZ_DD;
            const float* wg = INP(17) + (size_t)l * NE * SZ_EXP; const float* wu = INP(18) + (size_t)l * NE * SZ_EXP; const float* wd = INP(19) + (size_t)l * NE * SZ_EXP;
            const float* wsg = INP(20) + (size_t)l * SZ_EXP; const float* wsu = INP(21) + (size_t)l * SZ_EXP; const float* wsd = INP(22) + (size_t)l * SZ_EXP;
            bf16* pWin = WinT; bf16* pWout = WoutT; bf16* pWq = WqT; bf16* pWo = WoT; bf16* pWgu = WguT; bf16* pWd = WdT;
            constexpr int I_IN = 32 * 68, I_DD = 1024, I_E = 256, NIT = I_IN + 3 * I_DD + 3 * 65 * I_E;
            for (int it = gw; it < NIT; it += NGW) {
                int r = it;
                if (r < I_IN) { tr_matrix_item<false>(w_in, D, INW, pWin, 0, r, scr, F.lane); continue; } r -= I_IN;
                if (r < I_DD) { tr_matrix_item<false>(w_out, D, D, pWout, 0, r, scr, F.lane); continue; } r -= I_DD;
                if (r < I_DD) { tr_matrix_item<false>(wq, D, D, pWq, 0, r, scr, F.lane); continue; } r -= I_DD;
                if (r < I_DD) { tr_matrix_item<false>(wo, D, D, pWo, 0, r, scr, F.lane); continue; } r -= I_DD;
                if (r < 65 * I_E) { const int e = r >> 8; tr_matrix_item8<true>(e < NE ? wg + (size_t)e * SZ_EXP : wsg, D, DE, (unsigned char*)pWgu + (size_t)e * 1024 * D, 0, r & 255, scr, F.lane, 64.0f); continue; } r -= 65 * I_E;
                if (r < 65 * I_E) { const int e = r >> 8; tr_matrix_item8<true>(e < NE ? wu + (size_t)e * SZ_EXP : wsu, D, DE, (unsigned char*)pWgu + (size_t)e * 1024 * D, 128, r & 255, scr, F.lane, 64.0f); continue; } r -= 65 * I_E;
                { const int e = r >> 8; tr_matrix_item8<false>(e < NE ? wd + (size_t)e * SZ_EXP : wsd, DE, D, (unsigned char*)pWd + (size_t)e * D * DE, 0, r & 255, scr, F.lane, 64.0f); }
            }
        }
        SEAM(pb + 0);
        if (KIND_EN(3) && IN(pb + 1)) for (int rep = 0; rep < NREP(3); ++rep) { relaunder(F);
            pg8::ProbStatic P{(const char*)hb, (const char*)WinT, D, D, D, (size_t)256 * D * 2, 0, 0, (size_t)256 * D * 2, 0, 1, {}}; P.S.init(M / 256, INW / 256, F.G, F.bid);
            pg8::EpiBf16 E{proj, INW, 1.0f}; pg8::gemm_phase<pg8::EpiBf16, pg8::ProbStatic, true>(F.lds, P, E, F.tid);
        }
        SEAM(pb + 1);
        if (KIND_EN(4) && IN(pb + 2)) for (int rep = 0; rep < NREP(4); ++rep) { relaunder(F); attn_phase(F, proj, INP(3) + l * 16, oA, oB, lseB); }
        SEAM(pb + 2);
        if (KIND_EN(5) && IN(pb + 3)) for (int rep = 0; rep < NREP(5); ++rep) { relaunder(F); merge_phase(F, oA, oB, lseB, INP(4) + l * 1024, INP(5) + l * 1024, mixed); }
        SEAM(pb + 3);
        if (KIND_EN(6) && IN(pb + 4)) for (int rep = 0; rep < NREP(6); ++rep) { relaunder(F);
            pg8::ProbStatic P{(const char*)mixed, (const char*)WoutT, D, D, D, (size_t)256 * D * 2, 0, 0, (size_t)256 * D * 2, 0, 1, {}}; P.S.init(M / 256, D / 256, F.G, F.bid);
            pg8::EpiResF32 E{hres, ybuf, D, ALPHA}; pg8::gemm_phase<pg8::EpiResF32, pg8::ProbStatic, true>(F.lds, P, E, F.tid);
        }
        SEAM(pb + 4);
        if (KIND_EN(7) && IN(pb + 5)) for (int rep = 0; rep < NREP(7); ++rep) { relaunder(F); ln_phase(F, ybuf, INP(7) + l * D, INP(8) + l * D, hbuf, hb, nullptr); }
        SEAM(pb + 5);
        if (KIND_EN(8) && IN(pb + 6)) for (int rep = 0; rep < NREP(8); ++rep) { relaunder(F);
            pg8::ProbStatic P{(const char*)hb, (const char*)WqT, D, D, D, (size_t)256 * D * 2, 0, 0, (size_t)256 * D * 2, 0, 1, {}}; P.S.init(M / 256, D / 256, F.G, F.bid);
            pg8::EpiBf16 E{qb, D, 1.0f}; pg8::gemm_phase<pg8::EpiBf16, pg8::ProbStatic, true>(F.lds, P, E, F.tid);
        }
        SEAM(pb + 6);
        if (KIND_EN(9) && IN(pb + 7)) for (int rep = 0; rep < NREP(9); ++rep) { relaunder(F);
            pg8::ProbStatic P{(const char*)qb, (const char*)(Kc + (size_t)l * D), D, 2 * D, 512, (size_t)256 * D * 2, (size_t)512 * 2, 0, (size_t)512 * 2, (size_t)256 * 2 * D * 2, 16, {}}; P.S.init(M / 256, 4, F.G, F.bid);
            pg8::EpiSoftmax E{Pb, 1024, 0.044194173824159216f * LOG2E}; pg8::gemm_phase<pg8::EpiSoftmax, pg8::ProbStatic, false>(F.lds, P, E, F.tid);
        }
        SEAM(pb + 7);
        if (KIND_EN(10) && IN(pb + 8)) for (int rep = 0; rep < NREP(10); ++rep) { relaunder(F);
            pg8::ProbStatic P{(const char*)Pb, (const char*)(VT + (size_t)l * D * 1024), 1024, 1024, 256, (size_t)256 * 1024 * 2, (size_t)256 * 2, 1, (size_t)256 * 1024 * 2, (size_t)256 * 2, 16, {}}; P.S.init(M / 256, 8, F.G, F.bid);
            pg8::EpiBf16 E{ob, D, 1.0f}; pg8::gemm_phase<pg8::EpiBf16, pg8::ProbStatic, true>(F.lds, P, E, F.tid);
        }
        SEAM(pb + 8);
        if (KIND_EN(11) && IN(pb + 9)) for (int rep = 0; rep < NREP(11); ++rep) { relaunder(F);
            pg8::ProbStatic P{(const char*)ob, (const char*)WoT, D, D, D, (size_t)256 * D * 2, 0, 0, (size_t)256 * D * 2, 0, 1, {}}; P.S.init(M / 256, D / 256, F.G, F.bid);
            pg8::EpiResF32 E{hbuf, ybuf, D, ALPHA}; pg8::gemm_phase<pg8::EpiResF32, pg8::ProbStatic, true>(F.lds, P, E, F.tid);
        }
        SEAM(pb + 9);
        if (KIND_EN(12) && IN(pb + 10)) for (int rep = 0; rep < NREP(12); ++rep) { relaunder(F); ln_phase(F, ybuf, INP(13) + l * D, INP(14) + l * D, hbuf, nullptr, (unsigned char*)hb); }
        SEAM(pb + 10);
        if (KIND_EN(13) && IN(pb + 11)) for (int rep = 0; rep < NREP(13); ++rep) { relaunder(F); router_phase(F, hbuf, INP(15) + (size_t)l * D * NE, INP(16) + l * NE, F.ctl + CW_CNT + ((rep + 1 < NREP(13)) ? 1024 : 0) + l * 64, tok_e, tok_slot, tok_gate, row_tok, row_gate); }
        SEAM(pb + 11);
        if (KIND_EN(14) && IN(pb + 12)) { relaunder(F); scatter_phase(F, F.ctl + CW_CNT + l * 64, tok_e, tok_slot, tok_gate, tok_pos, row_tok, row_gate, meta); }
        SEAM(pb + 12);
        if (KIND_EN(15) && IN(pb + 13)) for (int rep = 0; rep < NREP(15); ++rep) { relaunder(F);
            LAS int* blkexp = (LAS int*)(F.lds + BLKEXP_OFF); LAS int* tokbuf = (LAS int*)(F.lds + TOKBUF_OFF); LAS float* gatebuf = (LAS float*)(F.lds + GATEBUF_OFF);
            const int nblk = meta[0];
            for (int i = F.tid; i < 640; i += NWAVES * 64) blkexp[i] = (i < nblk) ? meta[16 + i] : NE;
            __syncthreads();
            const int ntot = (nblk + 64) * 4;
            pg8::ProbMoe<true> P{(const char*)hb, (const char*)WguT, D / 2, D / 2, D / 2, 4, (size_t)1024 * D, (size_t)256 * D, blkexp, tokbuf, nblk, ntot, (ntot + 7) / 8, F.bid & 7, F.bid >> 3, F.G >> 3};
            for (int i = 0; i < MAXORD; ++i) { pg8::Unit u; if (!P.next(i, u)) break;
                if (F.tid < 256) tokbuf[i * 256 + F.tid] = row_tok[u.pm * 256 + F.tid]; else gatebuf[i * 256 + F.tid - 256] = row_gate[u.pm * 256 + F.tid - 256]; }
            __syncthreads();
            pg8::EpiSwiGLU8 E{(unsigned char*)hid, gatebuf}; pg8::gemm_phase<pg8::EpiSwiGLU8, pg8::ProbMoe<true>, true, true>(F.lds, P, E, F.tid);
        }
        SEAM(pb + 13);
        if (KIND_EN(16) && IN(pb + 14)) for (int rep = 0; rep < NREP(16); ++rep) { relaunder(F);
            LAS int* blkexp = (LAS int*)(F.lds + BLKEXP_OFF);
            const int nblk = meta[0];
            for (int i = F.tid; i < 640; i += NWAVES * 64) blkexp[i] = (i < nblk) ? meta[16 + i] : NE;
            __syncthreads();
            const int ntot = (nblk + 64) * 8;
            pg8::ProbMoe<false> P{(const char*)hid, (const char*)WdT, DE / 2, DE / 2, DE / 2, 8, (size_t)D * DE, (size_t)256 * DE, blkexp, nullptr, nblk, ntot, (ntot + 7) / 8, F.bid & 7, F.bid >> 3, F.G >> 3};
            pg8::EpiFp8 E{(unsigned char*)yrows, D, 0.015625f}; pg8::gemm_phase<pg8::EpiFp8, pg8::ProbMoe<false>, true, true>(F.lds, P, E, F.tid);
        }
        SEAM(pb + 14);
        if (KIND_EN(17) && IN(pb + 15)) for (int rep = 0; rep < NREP(17); ++rep) { relaunder(F); combine_phase(F, hbuf, (const unsigned char*)yrows, tok_pos, INP(23) + l * D, INP(24) + l * D, (rep + 1 < NREP(17)) ? ybuf : ((l == DEPTH - 1) ? OUTP : hbuf), (l == DEPTH - 1) ? nullptr : hb); }
        if (l + 1 < DEPTH) SEAM(pb + 15);
    }
    if (use_bar && hi == NPH) {
        if (__hip_atomic_load(F.ctl + CW_BAR + XB_TMO, RLX_AGENT) != 0u && F.tid == 0) { VM_WAIT(); OUTP[(size_t)F.bid * D] = __builtin_nanf(""); }
    }
#undef IN
#undef SEAM
}

extern "C" void kernel_launch(void* const* d_in, const int* in_sizes, int n_in, void* d_out, int out_size, void* d_ws, size_t ws_size, hipStream_t stream) {
    static int grid = 0;
    if (grid == 0) {
        if (n_in != 25 || in_sizes[0] != M * D || out_size != M * D || ws_size < WS_END) { fprintf(stderr, "kernel_launch: unexpected shapes (n_in %d, in0 %d, out %d, ws %zu, need %zu); nothing launched\n", n_in, n_in > 0 ? in_sizes[0] : -1, out_size, ws_size, (size_t)WS_END); grid = -1; return; }
        int dev = 0, cus = 0, per_cu = 0;
        if (hipGetDevice(&dev) != hipSuccess || hipDeviceGetAttribute(&cus, hipDeviceAttributeMultiprocessorCount, dev) != hipSuccess) { grid = -1; return; }
        if (hipFuncSetAttribute((const void*)mk_fwd, hipFuncAttributeMaxDynamicSharedMemorySize, LDS_BYTES) != hipSuccess) { fprintf(stderr, "kernel_launch: hipFuncSetAttribute failed\n"); grid = -1; return; }
        if (hipOccupancyMaxActiveBlocksPerMultiprocessor(&per_cu, (const void*)mk_fwd, NWAVES * 64, LDS_BYTES) != hipSuccess || per_cu < 1) fprintf(stderr, "kernel_launch: occupancy query reports %d\n", per_cu);
        (void)hipGetLastError();
        grid = cus;
        if (grid != 256) { fprintf(stderr, "kernel_launch: built for 256 CUs, device has %d; nothing launched\n", cus); grid = -1; return; }
    }
    if (grid < 0) return;
    if (hipMemsetAsync((char*)d_ws + WS_CTL, 0, CTL_ZERO_BYTES, stream) != hipSuccess) return;
    Args a{};
    for (int i = 0; i < 25; ++i) a.in[i] = (const float*)d_in[i];
    a.out = (float*)d_out; a.ws = (unsigned char*)d_ws;
#if MK_N_LAUNCHES == 1
    a.ph_lo = 0; a.ph_hi = NPH;
    hipLaunchKernelGGL(mk_fwd, dim3(grid), dim3(NWAVES * 64), LDS_BYTES, stream, a);
#else
    for (int p = 0; p < NPH; ++p) { a.ph_lo = p; a.ph_hi = p + 1; hipLaunchKernelGGL(mk_fwd, dim3(grid), dim3(NWAVES * 64), LDS_BYTES, stream, a); }
#endif
}
```
